# Optimizing an MI355X kernel written in HIP

```python
import jax
import jax.numpy as jnp
from jax import lax
import numpy as np

D_MODEL = 1024
BATCH = 16
SEQ = 2048
DEPTH = 1

GRID_W = 64
CTX_LEN = 256
EPS = 1e-6

MLA_HEADS = 8
QK_NOPE = 64
QK_ROPE = 32
QK_HEAD = QK_NOPE + QK_ROPE
V_HEAD = 64
Q_LORA = 256
KV_LORA = 128
ROPE_BASE = 10000.0
ATTN_SCALE = QK_HEAD ** -0.5
Q_BLOCK = 128
MLA_IN = Q_LORA + KV_LORA + QK_ROPE

RW_HEADS = 8
RW_HEAD = 64
RW_DIM = RW_HEADS * RW_HEAD
DECAY_LORA = 64
AICL_LORA = 64
GATE_LORA = 160
GN_EPS = 64e-5
SHIFT_WIDTH = 3
RW_SPLITS = (RW_DIM, RW_DIM, RW_DIM, DECAY_LORA, DECAY_LORA, AICL_LORA, AICL_LORA, GATE_LORA)
RW_IN = sum(RW_SPLITS)

N_BRANCH = 2
IN_WIDTH = MLA_IN + RW_IN + N_BRANCH * D_MODEL

N_EXPERTS = 256
TOP_K = 8
N_GROUPS = 8
TOPK_GROUPS = 4
EXPERT_FF = 256
ROUTED_SCALE = 2.5
DISPATCH_BLOCK = 128

kernel_name = 'hybrid_mla_rwkv7_moe_dit_layer'


def _split(x, sizes):
    return jnp.split(x, np.cumsum(sizes)[:-1].tolist(), axis=-1)


def rms_norm(x, gain):
    xf = x.astype(jnp.float32)
    y = xf * lax.rsqrt(jnp.mean(xf * xf, axis=-1, keepdims=True) + EPS)
    return (y * gain.astype(jnp.float32)).astype(x.dtype)


def modulate(x, shift, scale):
    return x * (1 + scale) + shift


def centred_conv(x, w):
    T = x.shape[1]
    pad = SHIFT_WIDTH // 2
    xp = jnp.pad(x, ((0, 0), (pad, pad), (0, 0)))
    return sum(xp[:, j:j + T] * w[j] for j in range(SHIFT_WIDTH))


def axial_rope(n_tokens, dtype):
    rows = n_tokens // GRID_W
    row = jnp.repeat(jnp.arange(rows, dtype=jnp.float32), GRID_W)
    col = jnp.tile(jnp.arange(GRID_W, dtype=jnp.float32), rows)
    n_freq = QK_ROPE // 4
    inv_freq = ROPE_BASE ** (-jnp.arange(n_freq, dtype=jnp.float32) / n_freq)
    ang = jnp.concatenate([row[:, None] * inv_freq, col[:, None] * inv_freq], axis=-1)
    return jnp.cos(ang).astype(dtype), jnp.sin(ang).astype(dtype)


def apply_rope(x, cos, sin):
    half = QK_ROPE // 2
    x_nope, x1, x2 = x[..., :QK_NOPE], x[..., QK_NOPE:QK_NOPE + half], x[..., QK_NOPE + half:]
    c, s = cos[:, None, :], sin[:, None, :]
    return jnp.concatenate([x_nope, x1 * c - x2 * s, x1 * s + x2 * c], axis=-1)


def mla_queries(q_lat, p, rope):
    B, T, _ = q_lat.shape
    q = (rms_norm(q_lat, p['q_lat_norm']) @ p['w_uq']).reshape(B, T, MLA_HEADS, QK_HEAD)
    q = rms_norm(q, p['q_norm'])
    return q if rope is None else apply_rope(q, *rope)


def mla_keys_values(kv_lat, k_rope, p, rope):
    B, T, _ = kv_lat.shape
    kv = (rms_norm(kv_lat, p['kv_lat_norm']) @ p['w_ukv']).reshape(B, T, MLA_HEADS, QK_NOPE + V_HEAD)
    k_nope, v = kv[..., :QK_NOPE], kv[..., QK_NOPE:]
    k_shared = jnp.broadcast_to(k_rope[:, :, None, :], (B, T, MLA_HEADS, QK_ROPE))
    k = rms_norm(jnp.concatenate([k_nope, k_shared], axis=-1), p['k_norm'])
    return (k if rope is None else apply_rope(k, *rope)), v


def attend(q, k, v):
    s = jnp.einsum('bqhd,bkhd->bhqk', q, k).astype(jnp.float32) * ATTN_SCALE
    w = jax.nn.softmax(s, axis=-1).astype(v.dtype)
    return jnp.einsum('bhqk,bkhd->bqhd', w, v)


def block_attention(q, k, v):
    B, T, H, Dh = q.shape
    nb = T // Q_BLOCK
    qb = q.reshape(B, nb, Q_BLOCK, H, Dh).swapaxes(0, 1)
    o = lax.map(lambda qblk: attend(qblk, k, v), qb)
    return o.swapaxes(0, 1).reshape(B, T, H * V_HEAD)


def rwkv_operands(rw, p):
    B, T, _ = rw.shape
    heads = lambda z: z.reshape(B, T, RW_HEADS, RW_HEAD)
    r, k, v, lw_f, lw_b, la_f, la_b, lg = _split(rw, RW_SPLITS)
    kk = heads(k * p['k_k']).astype(jnp.float32)
    kk = kk * lax.rsqrt(jnp.sum(kk * kk, axis=-1, keepdims=True) + 1e-12)
    dirs = []
    for d, (lw, la) in enumerate(((lw_f, la_f), (lw_b, la_b))):
        w_log = -jax.nn.softplus(-(p['decay_w0'][d] + jnp.tanh(lw) @ p['decay_w2'][d])) - 0.5
        decay = jnp.exp(-jnp.exp(w_log.astype(jnp.float32)))
        a = jax.nn.sigmoid(p['aicl_a0'][d] + la @ p['aicl_a2'][d])
        k_d = k * (1 + (a - 1) * p['k_a'])
        dirs.append((heads(decay), heads(k_d), heads(a)))
    return heads(r), heads(v), kk, dirs, lg


def wkv7_scan(state0, r, decay, k, v, kk, a, reverse, emit):
    f32 = jnp.float32
    seqs = (decay, k, v, kk, a) + ((r,) if emit else ())
    xs = tuple(jnp.moveaxis(z.astype(f32), 1, 0) for z in seqs)

    def step(S, inp):
        w_t, k_t, v_t, kk_t, a_t = inp[:5]
        sa = jnp.einsum('bhvk,bhk->bhv', S, -kk_t)
        S = (S * w_t[:, :, None, :] + sa[..., None] * (kk_t * a_t)[:, :, None, :]
             + v_t[..., None] * k_t[:, :, None, :])
        return S, (jnp.einsum('bhvk,bhk->bhv', S, inp[5]) if emit else None)

    S, ys = lax.scan(step, state0, xs, reverse=reverse)
    return S, (jnp.moveaxis(ys, 0, 1) if emit else None)


def rwkv_bidirectional(r, v, kk, dirs, init_states, emit):
    ys, states = [], []
    for d, (decay, k_d, a) in enumerate(dirs):
        S, y = wkv7_scan(init_states[d], r, decay, k_d, v, kk, a, d == 1, emit)
        states.append(S)
        ys.append(y)
    return (ys[0] + ys[1] if emit else None), (states[0], states[1])


def rwkv_readout(y, r, v, dirs, lg, p):
    B, T = y.shape[:2]
    mu = jnp.mean(y, axis=-1, keepdims=True)
    var = jnp.mean(jnp.square(y - mu), axis=-1, keepdims=True)
    y_n = ((y - mu) * lax.rsqrt(var + GN_EPS)).reshape(B, T, RW_DIM)
    y_n = y_n * p['gn_w'].astype(jnp.float32) + p['gn_b'].astype(jnp.float32)
    k_sum = dirs[0][1] + dirs[1][1]
    bonus = jnp.sum(r * k_sum * p['r_k'], axis=-1, keepdims=True) * v
    g = jax.nn.sigmoid(lg) @ p['gate_g2']
    return (y_n.astype(v.dtype) + bonus.reshape(B, T, RW_DIM)) * g


def merge_branches(att, rw, gate_logits, p):
    g_att, g_rw = jnp.split(jax.nn.sigmoid(gate_logits), N_BRANCH, axis=-1)
    return (g_att * (att @ p['w_o_mla']) + g_rw * (rw @ p['w_o_rwkv'])) @ p['w_out']


def token_mixers(h_lat, h_ctx, p, update_ctx):
    B, T, _ = h_lat.shape
    C = h_ctx.shape[1]
    in_sizes = (MLA_IN, RW_IN, N_BRANCH * D_MODEL)
    mla_l, rw_l, gate_l = _split(h_lat @ p['w_in'], in_sizes)
    mla_c, rw_c, gate_c = _split(h_ctx @ p['w_in'], in_sizes)
    mla_sizes = (Q_LORA, KV_LORA, QK_ROPE)
    q_lat_l, kv_lat_l, kr_l = _split(mla_l, mla_sizes)
    q_lat_c, kv_lat_c, kr_c = _split(mla_c, mla_sizes)

    rope = axial_rope(T, h_lat.dtype)
    q_l = mla_queries(q_lat_l, p, rope)
    k_l, v_l = mla_keys_values(kv_lat_l, kr_l, p, rope)
    k_c, v_c = mla_keys_values(kv_lat_c, kr_c, p, None)
    att_l = block_attention(q_l, jnp.concatenate([k_l, k_c], axis=1), jnp.concatenate([v_l, v_c], axis=1))

    r_c, v_rc, kk_c, dirs_c, lg_c = rwkv_operands(centred_conv(rw_c, p['shift_conv']), p)
    r_l, v_rl, kk_l, dirs_l, lg_l = rwkv_operands(centred_conv(rw_l, p['shift_conv']), p)
    zero_state = jnp.zeros((B, RW_HEADS, RW_HEAD, RW_HEAD), jnp.float32)
    y_c, ctx_states = rwkv_bidirectional(r_c, v_rc, kk_c, dirs_c, (zero_state, zero_state), update_ctx)
    y_l, _ = rwkv_bidirectional(r_l, v_rl, kk_l, dirs_l, ctx_states, True)
    rw_out_l = rwkv_readout(y_l, r_l, v_rl, dirs_l, lg_l, p)
    mix_l = merge_branches(att_l, rw_out_l, gate_l, p)
    if not update_ctx:
        return mix_l, None
    att_c = attend(mla_queries(q_lat_c, p, None), k_c, v_c).reshape(B, C, MLA_HEADS * V_HEAD)
    rw_out_c = rwkv_readout(y_c, r_c, v_rc, dirs_c, lg_c, p)
    return mix_l, merge_branches(att_c, rw_out_c, gate_c, p)


def moe_ffn(u, p):
    B, T, D = u.shape
    n_tok = B * T
    t = u.reshape(n_tok, D)
    scores = jax.nn.sigmoid(t.astype(jnp.float32) @ p['router_w'].astype(jnp.float32))
    sel = scores + p['router_bias'].astype(jnp.float32)
    per_group = N_EXPERTS // N_GROUPS
    group_score = lax.top_k(sel.reshape(n_tok, N_GROUPS, per_group), 2)[0].sum(-1)
    _, top_groups = lax.top_k(group_score, TOPK_GROUPS)
    group_mask = jnp.any(top_groups[:, :, None] == jnp.arange(N_GROUPS)[None, None, :], axis=1)
    sel = jnp.where(jnp.repeat(group_mask, per_group, axis=1), sel, -jnp.inf)
    _, expert_idx = lax.top_k(sel, TOP_K)
    gate = jnp.take_along_axis(scores, expert_idx, axis=1)
    gate = (gate / jnp.sum(gate, axis=-1, keepdims=True) * ROUTED_SCALE).astype(u.dtype)

    n_assign = n_tok * TOP_K
    flat_e = expert_idx.reshape(-1)
    order = jnp.argsort(flat_e)
    sorted_e = flat_e[order]
    counts = jnp.bincount(flat_e, length=N_EXPERTS)
    padded = (counts + DISPATCH_BLOCK - 1) // DISPATCH_BLOCK * DISPATCH_BLOCK
    padded_end = jnp.cumsum(padded)
    rank = jnp.arange(n_assign) - (jnp.cumsum(counts) - counts)[sorted_e]
    dest = (padded_end - padded)[sorted_e] + rank
    n_blocks = -(-n_assign // DISPATCH_BLOCK) + N_EXPERTS
    slots = n_blocks * DISPATCH_BLOCK
    slot_tok = jnp.full((slots,), n_tok, jnp.int32).at[dest].set((order // TOP_K).astype(jnp.int32))
    slot_w = jnp.zeros((slots,), u.dtype).at[dest].set(gate.reshape(-1)[order])
    block_e = jnp.minimum(jnp.searchsorted(padded_end, jnp.arange(n_blocks) * DISPATCH_BLOCK, side='right'),
                          N_EXPERTS - 1)
    t_pad = jnp.concatenate([t, jnp.zeros((1, D), t.dtype)], axis=0)

    def expert_block(acc, blk):
        tok, wgt, e = blk
        xb = t_pad[tok]
        hb = jax.nn.silu(xb @ p['expert_w1'][e]) * (xb @ p['expert_w3'][e])
        return acc.at[tok].add((hb @ p['expert_w2'][e]) * wgt[:, None]), None

    acc, _ = lax.scan(expert_block, jnp.zeros((n_tok + 1, D), u.dtype),
                      (slot_tok.reshape(n_blocks, DISPATCH_BLOCK), slot_w.reshape(n_blocks, DISPATCH_BLOCK), block_e))
    shared = (jax.nn.silu(t @ p['shared_w1']) * (t @ p['shared_w3'])) @ p['shared_w2']
    return (acc[:n_tok] + shared).reshape(B, T, D)


def hybrid_layer(x, ctx, mod_lat, mod_ctx, p, update_ctx):
    sh_a, sc_a, g_a, sh_m, sc_m, g_m = jnp.split(mod_lat, 6, axis=-1)
    csh_a, csc_a, cg_a, csh_m, csc_m, cg_m = jnp.split(mod_ctx, 6, axis=-1)
    h_lat = modulate(rms_norm(x, p['norm_mix']), sh_a, sc_a)
    h_ctx = modulate(rms_norm(ctx, p['norm_mix']), csh_a, csc_a)
    mix_l, mix_c = token_mixers(h_lat, h_ctx, p, update_ctx)
    x = x + g_a * mix_l
    x = x + g_m * moe_ffn(modulate(rms_norm(x, p['norm_ffn']), sh_m, sc_m), p)
    if update_ctx:
        ctx = ctx + cg_a * mix_c
        ctx = ctx + cg_m * moe_ffn(modulate(rms_norm(ctx, p['norm_ffn']), csh_m, csc_m), p)
    return x, ctx


def setup_inputs(seed: int = 0) -> dict:
    key = jax.random.key(seed)
    ks = iter(jax.random.split(key, 40))
    nrm = lambda shape, scale: jax.random.normal(next(ks), shape, jnp.float32) * scale
    L, D, E, F = DEPTH, D_MODEL, N_EXPERTS, EXPERT_FF
    return {
        'x': nrm((BATCH, SEQ, D), 1.0),
        'c': nrm((BATCH, D), 1.0),
        'ctx': nrm((BATCH, CTX_LEN, D), 1.0),
        'c_ctx': nrm((D,), 1.0),
        'ada_w': nrm((L, D, 6 * D), 0.5 * D ** -0.5),
        'ada_b': nrm((L, 6 * D), 0.01),
        'norm_mix': 1.0 + nrm((L, D), 0.05),
        'norm_ffn': 1.0 + nrm((L, D), 0.05),
        'w_in': nrm((L, D, IN_WIDTH), D ** -0.5),
        'shift_conv': jnp.asarray([0.2, 0.6, 0.2], jnp.float32)[None, :, None] + nrm((L, SHIFT_WIDTH, RW_IN), 0.05),
        'q_lat_norm': 1.0 + nrm((L, Q_LORA), 0.05),
        'w_uq': nrm((L, Q_LORA, MLA_HEADS * QK_HEAD), Q_LORA ** -0.5),
        'kv_lat_norm': 1.0 + nrm((L, KV_LORA), 0.05),
        'w_ukv': nrm((L, KV_LORA, MLA_HEADS * (QK_NOPE + V_HEAD)), KV_LORA ** -0.5),
        'q_norm': 1.0 + nrm((L, QK_HEAD), 0.05),
        'k_norm': 1.0 + nrm((L, QK_HEAD), 0.05),
        'w_o_mla': nrm((L, MLA_HEADS * V_HEAD, D), (MLA_HEADS * V_HEAD) ** -0.5),
        'decay_w0': nrm((L, 2, RW_DIM), 0.5),
        'decay_w2': nrm((L, 2, DECAY_LORA, RW_DIM), 0.5 * DECAY_LORA ** -0.5),
        'aicl_a0': nrm((L, 2, RW_DIM), 0.5),
        'aicl_a2': nrm((L, 2, AICL_LORA, RW_DIM), 0.5 * AICL_LORA ** -0.5),
        'k_k': 0.85 + nrm((L, RW_DIM), 0.05),
        'k_a': 1.0 + nrm((L, RW_DIM), 0.05),
        'r_k': nrm((L, RW_HEADS, RW_HEAD), 0.1),
        'gn_w': 1.0 + nrm((L, RW_DIM), 0.05),
        'gn_b': nrm((L, RW_DIM), 0.01),
        'gate_g2': nrm((L, GATE_LORA, RW_DIM), GATE_LORA ** -0.5),
        'w_o_rwkv': nrm((L, RW_DIM, D), RW_DIM ** -0.5),
        'w_out': nrm((L, D, D), D ** -0.5),
        'router_w': nrm((L, D, E), D ** -0.5),
        'router_bias': nrm((L, E), 0.01),
        'expert_w1': nrm((L, E, D, F), D ** -0.5),
        'expert_w3': nrm((L, E, D, F), D ** -0.5),
        'expert_w2': nrm((L, E, F, D), F ** -0.5),
        'shared_w1': nrm((L, D, F), D ** -0.5),
        'shared_w3': nrm((L, D, F), D ** -0.5),
        'shared_w2': nrm((L, F, D), F ** -0.5),
    }


def reference(x, c, ctx, c_ctx, ada_w, ada_b, norm_mix, norm_ffn, w_in, shift_conv,
              q_lat_norm, w_uq, kv_lat_norm, w_ukv, q_norm, k_norm, w_o_mla,
              decay_w0, decay_w2, aicl_a0, aicl_a2, k_k, k_a, r_k, gn_w, gn_b, gate_g2, w_o_rwkv,
              w_out, router_w, router_bias, expert_w1, expert_w3, expert_w2,
              shared_w1, shared_w3, shared_w2):
    for i in range(DEPTH):
        p = dict(norm_mix=norm_mix[i], norm_ffn=norm_ffn[i], w_in=w_in[i], shift_conv=shift_conv[i],
                 q_lat_norm=q_lat_norm[i], w_uq=w_uq[i], kv_lat_norm=kv_lat_norm[i], w_ukv=w_ukv[i],
                 q_norm=q_norm[i], k_norm=k_norm[i], w_o_mla=w_o_mla[i],
                 decay_w0=decay_w0[i], decay_w2=decay_w2[i], aicl_a0=aicl_a0[i], aicl_a2=aicl_a2[i],
                 k_k=k_k[i], k_a=k_a[i], r_k=r_k[i], gn_w=gn_w[i], gn_b=gn_b[i], gate_g2=gate_g2[i],
                 w_o_rwkv=w_o_rwkv[i], w_out=w_out[i], router_w=router_w[i], router_bias=router_bias[i],
                 expert_w1=expert_w1[i], expert_w3=expert_w3[i], expert_w2=expert_w2[i],
                 shared_w1=shared_w1[i], shared_w3=shared_w3[i], shared_w2=shared_w2[i])
        mod_lat = (jax.nn.silu(c) @ ada_w[i] + ada_b[i])[:, None, :]
        mod_ctx = (jax.nn.silu(c_ctx) @ ada_w[i] + ada_b[i])[None, None, :]
        x, ctx = hybrid_layer(x, ctx, mod_lat, mod_ctx, p, i < DEPTH - 1)
    return x
```

```cpp
#include <hip/hip_runtime.h>
#include <cstdio>
#include <cstdint>

#ifndef MK_ONE_LAUNCH
#define MK_ONE_LAUNCH 1
#endif
#ifndef MK_REP_MASK
#define MK_REP_MASK 0
#endif
#ifndef MK_LAST_PHASE
#define MK_LAST_PHASE 99
#endif

#define LAS __attribute__((address_space(3)))
typedef unsigned short bf16_t;
typedef short bf16x8 __attribute__((ext_vector_type(8)));
typedef float f32x16 __attribute__((ext_vector_type(16)));
typedef float f32x4 __attribute__((ext_vector_type(4)));
typedef float f32x2 __attribute__((ext_vector_type(2)));
typedef unsigned u32x4 __attribute__((ext_vector_type(4)));
typedef unsigned u32x2 __attribute__((ext_vector_type(2)));
typedef __bf16 bf16x2_t __attribute__((ext_vector_type(2)));
typedef int i32x4 __attribute__((ext_vector_type(4)));
typedef int i32x8 __attribute__((ext_vector_type(8)));

constexpr int D = 1024, NB = 16, SEQ = 2048, CTX = 256;
constexpr int NL = NB * SEQ, NC = NB * CTX, NT = NL + NC, KEYS = SEQ + CTX;
constexpr int INW = 4416, PAW = 2368, GW = 2048;
constexpr int RW0 = 416;
constexpr int NEXP = 256, FF = 256, TOPK = 8;
constexpr int NSLOT_R = NL * TOPK, NSLOT = NSLOT_R + NL;
constexpr int NTHREADS = 512;
constexpr float EPS = 1e-6f, GN_EPS = 64e-5f;
constexpr float QSCALE = 0.10206207261596577f * 1.4426950408889634f;

constexpr size_t MiB = 1u << 20;
constexpr size_t WS_CTL = 0;
constexpr size_t CTL_BYTES = 64 * 1024;
constexpr size_t WS_MOD = 1 * MiB;
constexpr size_t WS_ROPE = WS_MOD + 512 * 1024;
constexpr size_t WS_WIN_T = 2 * MiB;
constexpr size_t WS_WO_T = 11 * MiB;
constexpr size_t WS_WOUT_T = 13 * MiB;
constexpr size_t WS_WR_T = 15 * MiB;
constexpr size_t WS_SSQ = 16 * MiB;
constexpr size_t WS_WQKV_T = 18 * MiB;
constexpr size_t WS_WLORA_T = 19 * MiB;
constexpr size_t WS_WG2_T = 20 * MiB;
constexpr size_t WS_H = 22 * MiB;
constexpr size_t WS_PA = WS_H + 72 * MiB;
constexpr size_t WS_GATES = WS_PA + 167 * MiB;
constexpr size_t WS_QRAW = WS_GATES + 128 * MiB;
constexpr size_t WS_K = WS_QRAW + 48 * MiB;
constexpr size_t WS_VT = WS_K + 54 * MiB;
constexpr size_t WS_ATT = WS_VT + 36 * MiB;
constexpr size_t WS_R = WS_ATT + 32 * MiB;
constexpr size_t WS_KB = WS_R + 36 * MiB;
constexpr size_t WS_V = WS_KB + 36 * MiB;
constexpr size_t WS_KK = WS_V + 36 * MiB;
constexpr size_t WS_LORA = WS_KK + 36 * MiB;
constexpr size_t WS_GATEA = WS_LORA + 18 * MiB;
constexpr size_t WS_KD = WS_GATEA + 16 * MiB;
constexpr size_t WS_Y = WS_KD + 72 * MiB;
constexpr size_t WS_RWOUT = WS_Y + 64 * MiB;
constexpr size_t WS_MERGED = WS_PA;
constexpr size_t WS_END1 = WS_RWOUT + 32 * MiB;
constexpr size_t WS_W2T = WS_LORA;
constexpr size_t WS_W13T = WS_RWOUT + 16 * MiB;
static_assert(WS_W2T + 65 * MiB <= WS_Y && WS_W13T + 129 * MiB <= 1024 * MiB, "expert weight copies");
constexpr size_t WS_BB = WS_H;
constexpr size_t WS_WB = WS_PA;
constexpr size_t WS_TOPE = 22 * MiB;
constexpr size_t WS_TOPP = WS_TOPE + 1 * MiB;
constexpr size_t WS_LTOK = WS_TOPP + 1 * MiB;
constexpr size_t WS_LGATE = WS_LTOK + 32 * MiB;
constexpr size_t WS_HB = WS_LGATE + 32 * MiB;
constexpr size_t WS_SCORE = WS_HB;
constexpr size_t WS_YB = WS_HB + 273 * MiB;
constexpr size_t WS_U = WS_YB;
constexpr size_t WS_U8 = WS_U + 64 * MiB;
constexpr size_t WS_END2 = WS_YB + 288 * MiB;
static_assert(WS_END2 <= WS_W2T, "y slots below the expert weight copies");
static_assert(WS_END1 <= 1024 * MiB && WS_END2 <= 1024 * MiB, "workspace map");

constexpr int CW_BAR = 1024;
constexpr int CW_CNT = 8192;

__device__ __forceinline__ unsigned pk2(float lo, float hi) { f32x2 v = {lo, hi}; bf16x2_t b = __builtin_convertvector(v, bf16x2_t); return __builtin_bit_cast(unsigned, b); }
__device__ __forceinline__ float bflo(unsigned u) { return __builtin_bit_cast(float, u << 16); }
__device__ __forceinline__ float bfhi(unsigned u) { return __builtin_bit_cast(float, u & 0xffff0000u); }
__device__ __forceinline__ float bf2f(bf16_t v) { return __builtin_bit_cast(float, ((unsigned)v) << 16); }
__device__ __forceinline__ bf16_t f2bf(float f) { return (bf16_t)(pk2(f, 0.f) & 0xffffu); }
__device__ __forceinline__ float fexp2(float x) { return __builtin_amdgcn_exp2f(x); }
__device__ __forceinline__ float fexp(float x) { return __builtin_amdgcn_exp2f(1.4426950408889634f * x); }
__device__ __forceinline__ float frcp(float x) { return __builtin_amdgcn_rcpf(x); }
__device__ __forceinline__ float sigmoidf_(float x) { return __builtin_amdgcn_rcpf(1.f + __builtin_amdgcn_exp2f(-1.4426950408889634f * x)); }
__device__ __forceinline__ float wave_sum(float v) {
#pragma unroll
    for (int o = 32; o >= 1; o >>= 1) v += __shfl_xor(v, o, 64);
    return v;
}
template <int CTRL> __device__ __forceinline__ float dpp_f(float v) { return __builtin_bit_cast(float, __builtin_amdgcn_update_dpp(0, __builtin_bit_cast(int, v), CTRL, 0xF, 0xF, true)); }
__device__ __forceinline__ float xor32(float v) { return __shfl_xor(v, 32, 64); }

#define XB_TMO      128
#define XB_XCNT(j)  (256  + 64 * (j))
#define XB_XSUB(j)  (1280 + 64 * (j))
#define XB_XGEN(j)  (2304 + 64 * (j))
#define XB_TOP      3328
#define XB_TOPGEN   3392
#define XCD_BAR_WORDS 3456
#define XB_SPIN_CAP (1u << 18)
__device__ __forceinline__ unsigned xb_ld(unsigned* p)              { return __hip_atomic_load(p, __ATOMIC_RELAXED, __HIP_MEMORY_SCOPE_AGENT); }
__device__ __forceinline__ unsigned xb_add(unsigned* p, unsigned v) { return __hip_atomic_fetch_add(p, v, __ATOMIC_RELAXED, __HIP_MEMORY_SCOPE_AGENT); }
__device__ __forceinline__ unsigned xb_xcc_id() { return (unsigned)__builtin_amdgcn_s_getreg((3 << 11) | 20) & 0xFu; }
#define XB_SPIN(cond, bar) do { unsigned _sp = 0; while (cond) { __builtin_amdgcn_s_sleep(1); \
    if ((++_sp & 255u) == 0u) { if (xb_ld(&(bar)[XB_TMO])) break; if (_sp > XB_SPIN_CAP) { atomicAdd(&(bar)[XB_TMO], 1u); break; } } } } while (0)
struct XcdBarrier { unsigned* bar; unsigned x; volatile LAS unsigned* st; };
__device__ __forceinline__ XcdBarrier xcd_barrier_post(unsigned* bar, volatile LAS unsigned* st) {
    XcdBarrier b; b.bar = bar; b.x = xb_xcc_id(); b.st = st;
    if (threadIdx.x == 0) (void)xb_add(&bar[XB_XCNT(b.x)], 1u);
    return b;
}
__device__ __forceinline__ void xcd_barrier_complete(unsigned* bar, unsigned x, unsigned& nloc, unsigned& nx) {
    const unsigned G = gridDim.x * gridDim.y * gridDim.z;
    unsigned sum, cnt, mine, sp = 0u;
    for (;;) {
        sum = 0u; cnt = 0u; mine = 0u;
#pragma unroll
        for (unsigned j = 0; j < 16; ++j) { const unsigned c = xb_ld(&bar[XB_XCNT(j)]); sum += c; cnt += (c > 0u) ? 1u : 0u; mine = (j == x) ? c : mine; }
        if (sum == G) break;
        __builtin_amdgcn_s_sleep(1);
        if ((++sp & 255u) == 0u) { if (xb_ld(&bar[XB_TMO])) break; if (sp > XB_SPIN_CAP) { atomicAdd(&bar[XB_TMO], 1u); break; } }
    }
    nloc = mine > 0u ? mine : 1u; nx = cnt > 0u ? cnt : 1u;
}
__device__ __forceinline__ void xcd_barrier(const XcdBarrier& b) {
    asm volatile("s_waitcnt vmcnt(0)" ::: "memory");
    __syncthreads();
    if (threadIdx.x == 0) {
        unsigned* bar = b.bar;
        __builtin_amdgcn_s_waitcnt(0);
        unsigned nloc = b.st[0], nx = b.st[1];
        if (nloc == 0u) { xcd_barrier_complete(bar, b.x, nloc, nx); b.st[0] = nloc; b.st[1] = nx; }
        const unsigned old = xb_add(&bar[XB_XSUB(b.x)], 1u);
        const unsigned gen = old / nloc;
        if (old + 1u == (gen + 1u) * nloc) {
            __builtin_amdgcn_fence(__ATOMIC_RELEASE, "agent");
            asm volatile("s_waitcnt vmcnt(0)" ::: "memory");
            const unsigned og = xb_add(&bar[XB_TOP], 1u);
            const unsigned tg = og / nx;
            if (og + 1u == (tg + 1u) * nx) xb_add(&bar[XB_TOPGEN], 1u);
            else XB_SPIN(xb_ld(&bar[XB_TOPGEN]) == tg, bar);
            __builtin_amdgcn_fence(__ATOMIC_ACQUIRE, "agent");
            xb_add(&bar[XB_XGEN(b.x)], 1u);
            asm volatile("s_waitcnt vmcnt(0)" ::: "memory");
        } else {
            XB_SPIN(xb_ld(&bar[XB_XGEN(b.x)]) == gen, bar);
            __builtin_amdgcn_fence(__ATOMIC_ACQUIRE, "agent");
            asm volatile("s_waitcnt vmcnt(0)" ::: "memory");
        }
    }
    __syncthreads();
}

namespace pg8 {
constexpr int BM = 256, BK = 64, HALF = 128, HTB = HALF * BK * 2, STAGE_BYTES = 8 * HTB;
__device__ __forceinline__ int lds_byte(int r, int c) { const int st = (r >> 4) * 2 + (c >> 5), rr = r & 15, cc = c & 31, ob = rr * 64 + cc * 2; return st * 1024 + (ob ^ (((ob >> 9) & 1) << 5)); }
__device__ __forceinline__ void stage_rc(int b, int& R, int& C) { const int st = b / 1024, sb = b % 1024, swz = sb ^ (((sb >> 9) & 1) << 5); R = (st >> 1) * 16 + swz / 64; C = (st & 1) * 32 + (swz % 64) / 2; }
__device__ __forceinline__ int perm32(int rho) { const int n = rho >> 4, i = rho & 15; return 8 * (i >> 2) + 4 * n + (i & 3); }
struct Unit { int pm, pn, e, cnt, s0, k; };

__device__ __forceinline__ i32x8 cat8(const bf16x8 a, const bf16x8 b) { const i32x4 x = __builtin_bit_cast(i32x4, a), y = __builtin_bit_cast(i32x4, b); return __builtin_shufflevector(x, y, 0, 1, 2, 3, 4, 5, 6, 7); }
template <class Epi, class Sched, class AOff, bool ALIGN_EPI, bool F8 = false, bool VARK = false>
__device__ __forceinline__ void gemm_phase(LAS unsigned char* lds, const char* Abase, const char* Btbase, const int K, const Sched& S, const Epi& E, const AOff& AO) {
    const int tid = threadIdx.x, wid = __builtin_amdgcn_readfirstlane(tid >> 6), lane = tid & 63, wr = wid >> 2, wc = wid & 3, fr = lane & 15, fq = lane >> 4;
    const int nt = K / BK;
    unsigned voffB[2];
#pragma unroll
    for (int i = 0; i < 2; ++i) { int R_, C_; stage_rc(tid * 16 + i * 8192, R_, C_); const int Rb = Epi::PERM ? ((R_ & ~31) + perm32(R_ & 31)) : R_; voffB[i] = (unsigned)(Rb * K + C_) * 2u; }
    const size_t kstep = (size_t)(BK * 2);
    const size_t hstep = (size_t)HALF * K * 2;
    const size_t tstep = 2 * hstep;
    const unsigned ldsw = (unsigned)wid * 1024u;
    const int aoff = lds_byte(wr * 64 + fr, fq * 8), boff = lds_byte(wc * 32 + fr, fq * 8);
#define PG8_SA(b, h) (((b) * 2 + (h)) * HTB)
#define PG8_SB(b, h) ((4 + (b) * 2 + (h)) * HTB)
#define PG8_STAGEB(bufoff, gbase) do { _Pragma("unroll") for (int _i = 0; _i < 2; ++_i) \
        __builtin_amdgcn_global_load_lds((const unsigned*)((const char*)(gbase) + voffB[_i]), (LAS unsigned*)(lds + (bufoff) + ldsw + _i * 8192), 16, 0, 0); } while (0)
#define PG8_STAGEA(bufoff, offs, h, kb) do { _Pragma("unroll") for (int _i = 0; _i < 2; ++_i) \
        __builtin_amdgcn_global_load_lds((const unsigned*)(Abase + (size_t)(offs)[h][_i] + (kb)), (LAS unsigned*)(lds + (bufoff) + ldsw + _i * 8192), 16, 0, 0); } while (0)
#define PG8_LDA(dst, b, h) do { _Pragma("unroll") for (int m = 0; m < 4; ++m) _Pragma("unroll") for (int k = 0; k < 2; ++k) dst[m][k] = *(const LAS bf16x8*)(lds + PG8_SA(b, h) + aoff + m * 2048 + k * 1024); } while (0)
#define PG8_LDB(dst, b, h) do { _Pragma("unroll") for (int n = 0; n < 2; ++n) _Pragma("unroll") for (int k = 0; k < 2; ++k) dst[n][k] = *(const LAS bf16x8*)(lds + PG8_SB(b, h) + boff + n * 2048 + k * 1024); } while (0)
#define PG8_MMA(ai, bj, At, Bt) do { __builtin_amdgcn_s_setprio(1); _Pragma("unroll") for (int m = 0; m < 4; ++m) _Pragma("unroll") for (int n = 0; n < 2; ++n) { \
        if constexpr (F8) asm volatile("v_mfma_f32_16x16x128_f8f6f4 %0, %1, %2, %0" : "+v"(acc[ai][bj][m][n]) : "v"(cat8(Bt[n][0], Bt[n][1])), "v"(cat8(At[m][0], At[m][1]))); \
        else { _Pragma("unroll") for (int k = 0; k < 2; ++k) acc[ai][bj][m][n] = __builtin_amdgcn_mfma_f32_16x16x32_bf16(Bt[n][k], At[m][k], acc[ai][bj][m][n], 0, 0, 0); } } __builtin_amdgcn_s_setprio(0); } while (0)
#define PG8_WAIT_V(n) asm volatile("s_waitcnt vmcnt(" #n ")" ::: "memory")
#define PG8_WAIT_L(n) asm volatile("s_waitcnt lgkmcnt(" #n ")" ::: "memory")
#define PG8_BAR __builtin_amdgcn_s_barrier()
#define PG8_SCHED __builtin_amdgcn_sched_barrier(0)
    Unit cur, nxt; int ui = 0;
    if (!S.next(0, cur)) return;
    f32x4 acc[2][2][4][2];
#pragma unroll
    for (int a = 0; a < 2; ++a)
#pragma unroll
        for (int b = 0; b < 2; ++b)
#pragma unroll
            for (int m = 0; m < 4; ++m)
#pragma unroll
                for (int n = 0; n < 2; ++n) acc[a][b][m][n] = (f32x4){0.f, 0.f, 0.f, 0.f};
    bf16x8 At[4][2], B0[2][2], B1[2][2];
    unsigned ao[2][2], nao[2][2];
    AO.get(cur, tid, K, ao);
    const char* cB = Btbase + (size_t)cur.pn * tstep;
    int c_kb = 0, c_ks = (int)kstep, c_nt = nt, n_kb = 0, n_ks = (int)kstep, n_nt = nt;
    if constexpr (VARK) S.kp(cur, c_kb, c_ks, c_nt);
    PG8_STAGEB(PG8_SB(0, 0), cB + c_kb); PG8_STAGEB(PG8_SB(0, 1), cB + hstep + c_kb); PG8_STAGEA(PG8_SA(0, 0), ao, 0, (size_t)c_kb); PG8_STAGEA(PG8_SA(0, 1), ao, 1, (size_t)c_kb);
    if (wr == 1) PG8_BAR;
    PG8_WAIT_V(2); PG8_BAR;
    PG8_STAGEB(PG8_SB(1, 0), cB + c_kb + c_ks); PG8_STAGEA(PG8_SA(1, 0), ao, 0, (size_t)(c_kb + c_ks)); PG8_STAGEB(PG8_SB(1, 1), cB + hstep + c_kb + c_ks);
    PG8_WAIT_V(6); PG8_BAR;
    for (;;) {
        const bool has_next = S.next(ui + 1, nxt);
        if (has_next) AO.get(nxt, tid, K, nao);
        else {
#pragma unroll
            for (int h = 0; h < 2; ++h)
#pragma unroll
                for (int i = 0; i < 2; ++i) nao[h][i] = ao[h][i];
        }
        const char* nB = has_next ? Btbase + (size_t)nxt.pn * tstep : cB;
        if constexpr (VARK) { if (has_next) S.kp(nxt, n_kb, n_ks, n_nt); else { n_kb = c_kb; n_ks = c_ks; n_nt = c_nt; } }
        const bool half1 = !(cur.cnt > 0 && cur.cnt - cur.pm * 256 <= 128);
        for (int t = 0; t < c_nt; t += 2) {
            const bool last = (t == c_nt - 2);
            const size_t k1 = (size_t)c_kb + (size_t)t * kstep + (size_t)c_ks;
            const size_t k2 = last ? (size_t)n_kb : (size_t)c_kb + (size_t)(t + 2) * kstep, k3 = k2 + (size_t)(last ? n_ks : c_ks);
            unsigned o2[2][2];
#pragma unroll
            for (int h = 0; h < 2; ++h)
#pragma unroll
                for (int i = 0; i < 2; ++i) o2[h][i] = last ? nao[h][i] : ao[h][i];
            const char* b2 = last ? nB + n_kb : cB + c_kb + (size_t)(t + 2) * kstep; const char* b3 = b2 + (last ? n_ks : c_ks);
            PG8_LDB(B0, 0, 0); PG8_LDB(B1, 0, 1); PG8_SCHED; PG8_LDA(At, 0, 0); PG8_STAGEA(PG8_SA(1, 1), ao, 1, k1);
            PG8_WAIT_V(8); PG8_WAIT_L(0); PG8_BAR; PG8_MMA(0, 0, At, B0); PG8_MMA(0, 1, At, B1); PG8_BAR; PG8_SCHED;
            PG8_LDA(At, 0, 1); PG8_STAGEB(PG8_SB(0, 0), b2); PG8_STAGEB(PG8_SB(0, 1), b2 + hstep); PG8_STAGEA(PG8_SA(0, 0), o2, 0, k2);
            PG8_WAIT_V(8); PG8_WAIT_L(0); PG8_BAR; if (half1) { PG8_MMA(1, 0, At, B0); PG8_MMA(1, 1, At, B1); } PG8_BAR; PG8_SCHED;
            PG8_LDB(B0, 1, 0); PG8_LDB(B1, 1, 1); PG8_SCHED; PG8_LDA(At, 1, 0); PG8_STAGEA(PG8_SA(0, 1), o2, 1, k2);
            PG8_WAIT_V(8); PG8_WAIT_L(0); PG8_BAR; PG8_MMA(0, 0, At, B0); PG8_MMA(0, 1, At, B1); PG8_BAR; PG8_SCHED;
            PG8_LDA(At, 1, 1); PG8_STAGEB(PG8_SB(1, 0), b3); PG8_STAGEB(PG8_SB(1, 1), b3 + hstep); PG8_STAGEA(PG8_SA(1, 0), o2, 0, k3);
            PG8_WAIT_V(8); PG8_WAIT_L(0); PG8_BAR; if (half1) { PG8_MMA(1, 0, At, B0); PG8_MMA(1, 1, At, B1); } PG8_BAR; PG8_SCHED;
        }
        if constexpr (F8) asm volatile("s_nop 15\n\ts_nop 7" ::: "memory");
        if constexpr (ALIGN_EPI) { if (wr == 0) PG8_BAR; }
        E(acc, cur, wr, wc, fr, fq);
        if (!has_next) break;
#pragma unroll
        for (int a = 0; a < 2; ++a)
#pragma unroll
            for (int b = 0; b < 2; ++b)
#pragma unroll
                for (int m = 0; m < 4; ++m)
#pragma unroll
                    for (int n = 0; n < 2; ++n) acc[a][b][m][n] = (f32x4){0.f, 0.f, 0.f, 0.f};
        cur = nxt; cB = nB; ++ui; c_kb = n_kb; c_ks = n_ks; c_nt = n_nt;
#pragma unroll
        for (int h = 0; h < 2; ++h)
#pragma unroll
            for (int i = 0; i < 2; ++i) ao[h][i] = nao[h][i];
        if constexpr (ALIGN_EPI) { if (wr == 1) PG8_BAR; }
    }
    PG8_WAIT_V(0);
    if constexpr (!ALIGN_EPI) { if (wr == 0) PG8_BAR; }
    PG8_BAR;
#undef PG8_SA
#undef PG8_SB
#undef PG8_STAGEA
#undef PG8_STAGEB
#undef PG8_LDA
#undef PG8_LDB
#undef PG8_MMA
#undef PG8_WAIT_V
#undef PG8_WAIT_L
#undef PG8_BAR
#undef PG8_SCHED
}

struct APlain { __device__ __forceinline__ void get(const Unit& u, int tid, int K, unsigned (&o)[2][2]) const { int R[2], C[2]; stage_rc(tid * 16, R[0], C[0]); stage_rc(tid * 16 + 8192, R[1], C[1]);
#pragma unroll
    for (int h = 0; h < 2; ++h)
#pragma unroll
        for (int i = 0; i < 2; ++i) o[h][i] = (unsigned)((u.pm * 256 + h * 128 + R[i]) * K + C[i]) * 2u; } };
struct ATwo { unsigned delta; __device__ __forceinline__ void get(const Unit& u, int tid, int K, unsigned (&o)[2][2]) const { int R[2], C[2]; stage_rc(tid * 16, R[0], C[0]); stage_rc(tid * 16 + 8192, R[1], C[1]);
#pragma unroll
    for (int h = 0; h < 2; ++h)
#pragma unroll
        for (int i = 0; i < 2; ++i) o[h][i] = (unsigned)((u.pm * 256 + h * 128 + R[i]) * K + C[i]) * 2u + (u.k ? delta : 0u); } };
struct AGather { const int* ltok; __device__ __forceinline__ void get(const Unit& u, int tid, int K, unsigned (&o)[2][2]) const { int R[2], C[2]; stage_rc(tid * 16, R[0], C[0]); stage_rc(tid * 16 + 8192, R[1], C[1]);
#pragma unroll
    for (int h = 0; h < 2; ++h)
#pragma unroll
        for (int i = 0; i < 2; ++i) { int p = u.pm * 256 + h * 128 + R[i]; if (p >= u.cnt) p = 0; const int tok = (u.e < 256) ? ltok[(size_t)u.e * NL + p] : p; o[h][i] = (unsigned)(tok * K + C[i]) * 2u; } } };
struct ASlot { __device__ __forceinline__ void get(const Unit& u, int tid, int K, unsigned (&o)[2][2]) const { int R[2], C[2]; stage_rc(tid * 16, R[0], C[0]); stage_rc(tid * 16 + 8192, R[1], C[1]);
#pragma unroll
    for (int h = 0; h < 2; ++h)
#pragma unroll
        for (int i = 0; i < 2; ++i) o[h][i] = (unsigned)((u.s0 + h * 128 + R[i]) * K + C[i]) * 2u; } };

struct SchedInProj { int vcu, G; __device__ __forceinline__ bool next(int i, Unit& u) const {
    const int x = vcu + i * G; if (x >= 2448) return false;
    if (x < 2304) { const int g = x / 144, r = x % 144; u.pn = r >> 3; u.pm = g * 8 + (r & 7); } else { const int w = x - 2304; u.pn = 1 + (w >> 4); u.pm = 128 + (w & 15); }
    u.e = 0; u.cnt = 0; u.s0 = 0; u.k = 0; return true; } };
struct SchedTiles { int vcu, G, two; __device__ __forceinline__ bool next(int i, Unit& u) const {
    const int j = vcu + (two ? (i >> 1) : i) * G; if (j >= 512) return false;
    const int g = j >> 5, r = j & 31; u.pm = g * 8 + (r & 7); u.k = two ? (i & 1) : 0; u.pn = (r >> 3) + 4 * u.k; u.e = 0; u.cnt = 0; u.s0 = 0; return true; } };
struct SchedRouter { int vcu, G; __device__ __forceinline__ bool next(int i, Unit& u) const { const int x = vcu + i * G; if (x >= 128) return false; u.pm = x; u.pn = 0; u.e = 0; u.cnt = 0; u.s0 = 0; u.k = 0; return true; } };
struct SchedMoe { int vcu, G, ntile, nsh; LAS const int* eoff; LAS const int* toff;
    __device__ __forceinline__ bool next(int i, Unit& u) const {
        const int x = vcu + i * G; if (x >= (ntile << nsh)) return false;
        const int ti = x >> nsh, pl = x & ((1 << nsh) - 1);
        int e = 0;
        if (toff[256] <= ti) e = 256;
        else {
#pragma unroll
            for (int s = 128; s >= 1; s >>= 1) if (toff[e + s] <= ti) e += s;
        }
        e = __builtin_amdgcn_readfirstlane(e);
        u.e = e; u.pm = __builtin_amdgcn_readfirstlane(ti - toff[e]); u.cnt = __builtin_amdgcn_readfirstlane(eoff[e + 1] - eoff[e]); u.s0 = __builtin_amdgcn_readfirstlane(eoff[e]) + u.pm * 256; u.pn = (e << nsh) + pl; u.k = pl; return true; } };
struct AProj { __device__ __forceinline__ void get(const Unit& u, int tid, int K, unsigned (&o)[2][2]) const { int R[2], C[2]; stage_rc(tid * 16, R[0], C[0]); stage_rc(tid * 16 + 8192, R[1], C[1]);
#pragma unroll
    for (int h = 0; h < 2; ++h)
#pragma unroll
        for (int i = 0; i < 2; ++i) o[h][i] = (unsigned)((u.pm * 256 + h * 128 + R[i]) * PAW + (u.k ? 256 : 0) + C[i]) * 2u; } };
struct SchedQKV { int vcu, G;
    __device__ __forceinline__ void kp(const Unit& u, int& kb, int& ks, int& nt) const { kb = 0; ks = BK * 2; nt = u.k ? 2 : 4; }
    __device__ __forceinline__ bool next(int i, Unit& u) const {
    const int x = vcu + i * G; if (x >= 960) return false;
    if (x < 384) { u.pm = x / 3; u.pn = x % 3; u.k = 0; } else { const int w = x - 384; u.pm = w >> 2; u.pn = 3 + (w & 3); u.k = 1; }
    u.e = 0; u.cnt = 0; u.s0 = 0; return true; } };
struct SchedP4 { int vcu, G;
    __device__ __forceinline__ void kp(const Unit& u, int& kb, int& ks, int& nt) const { if (u.k == 0) { kb = (u.pn >> 2) * (BK * 2); ks = 4 * BK; nt = 2; } else { kb = 0; ks = BK * 2; nt = 4; } }
    __device__ __forceinline__ bool next(int i, Unit& u) const {
    const int x = vcu + i * G; if (x >= 1152 + 256) return false;
    if (x < 1152) { u.pm = x >> 3; u.pn = x & 7; u.k = 0; } else { const int w = x - 1152; u.pm = w >> 1; u.pn = 8 + (w & 1); u.k = 1; }
    u.e = 0; u.cnt = 0; u.s0 = 0; return true; } };
struct SchedLin { int vcu, G, total, nsh; __device__ __forceinline__ bool next(int i, Unit& u) const {
    const int x = vcu + i * G; if (x >= total) return false; u.pm = x >> nsh; u.pn = x & ((1 << nsh) - 1); u.k = 0; u.e = 0; u.cnt = 0; u.s0 = 0; return true; } };
}

__device__ __forceinline__ void transpose_block_ex(const float* Wsrc, int N, int kvalid, const float* kscale, bf16_t* dst, int K, LAS float* scr, int lane) {
#pragma unroll
    for (int h2 = 0; h2 < 2; ++h2) {
        float v_[16];
#pragma unroll
        for (int i = 0; i < 16; ++i) { const int kk = 2 * (16 * h2 + i) + (lane >> 5); v_[i] = 0.f; if (kk < kvalid) { v_[i] = Wsrc[(size_t)kk * N + (lane & 31)]; if (kscale) v_[i] *= kscale[kk]; } }
#pragma unroll
        for (int i = 0; i < 16; ++i) scr[(2 * (16 * h2 + i) + (lane >> 5)) * 33 + (lane & 31)] = v_[i];
    }
    asm volatile("s_waitcnt lgkmcnt(0)" ::: "memory");
    const int c = lane & 7;
#pragma unroll
    for (int j = 0; j < 4; ++j) { const int n = (lane >> 3) + 8 * j; const LAS float* s = scr + (8 * c) * 33 + n;
        u32x4 o; o.x = pk2(s[0 * 33], s[1 * 33]); o.y = pk2(s[2 * 33], s[3 * 33]); o.z = pk2(s[4 * 33], s[5 * 33]); o.w = pk2(s[6 * 33], s[7 * 33]);
        *(u32x4*)(dst + (size_t)n * K + 8 * c) = o; }
    asm volatile("s_waitcnt lgkmcnt(0)" ::: "memory");
}
__device__ __forceinline__ void zero_block(bf16_t* dst, int K, int lane) {
    const int c = lane & 7;
#pragma unroll
    for (int j = 0; j < 4; ++j) { const int n = (lane >> 3) + 8 * j; *(u32x4*)(dst + (size_t)n * K + 8 * c) = (u32x4){0u, 0u, 0u, 0u}; }
}
__device__ __forceinline__ void transpose_block(const float* Wsrc, int N, bf16_t* dst, int K, LAS float* scr, int lane) {
#pragma unroll
    for (int h2 = 0; h2 < 2; ++h2) {
        float v_[16];
#pragma unroll
        for (int i = 0; i < 16; ++i) v_[i] = __builtin_nontemporal_load(Wsrc + (size_t)(2 * (16 * h2 + i) + (lane >> 5)) * N + (lane & 31));
#pragma unroll
        for (int i = 0; i < 16; ++i) scr[(2 * (16 * h2 + i) + (lane >> 5)) * 33 + (lane & 31)] = v_[i];
    }
    asm volatile("s_waitcnt lgkmcnt(0)" ::: "memory");
    const int c = lane & 7;
#pragma unroll
    for (int j = 0; j < 4; ++j) { const int n = (lane >> 3) + 8 * j; const LAS float* s = scr + (8 * c) * 33 + n;
        u32x4 o; o.x = pk2(s[0 * 33], s[1 * 33]); o.y = pk2(s[2 * 33], s[3 * 33]); o.z = pk2(s[4 * 33], s[5 * 33]); o.w = pk2(s[6 * 33], s[7 * 33]);
        *(u32x4*)(dst + (size_t)n * K + 8 * c) = o; }
    asm volatile("s_waitcnt lgkmcnt(0)" ::: "memory");
}

__device__ __forceinline__ void transpose_block_f8(const float* Wsrc, int N, unsigned char* dst, int Kb, LAS float* scr, int lane, float sc) {
#pragma unroll
    for (int h2 = 0; h2 < 2; ++h2) {
        float v_[16];
#pragma unroll
        for (int i = 0; i < 16; ++i) v_[i] = __builtin_nontemporal_load(Wsrc + (size_t)(2 * (16 * h2 + i) + (lane >> 5)) * N + (lane & 31));
#pragma unroll
        for (int i = 0; i < 16; ++i) scr[(2 * (16 * h2 + i) + (lane >> 5)) * 33 + (lane & 31)] = v_[i] * sc;
    }
    asm volatile("s_waitcnt lgkmcnt(0)" ::: "memory");
    const int c = lane & 3;
#pragma unroll
    for (int j = 0; j < 2; ++j) { const int n = (lane >> 2) + 16 * j; const LAS float* s = scr + (16 * c) * 33 + n;
        u32x4 o;
#pragma unroll
        for (int q = 0; q < 4; ++q) { int w = __builtin_amdgcn_cvt_pk_fp8_f32(s[(4 * q) * 33], s[(4 * q + 1) * 33], 0, false); w = __builtin_amdgcn_cvt_pk_fp8_f32(s[(4 * q + 2) * 33], s[(4 * q + 3) * 33], w, true); o[q] = (unsigned)w; }
        *(u32x4*)(dst + (size_t)n * Kb + 16 * c) = o; }
    asm volatile("s_waitcnt lgkmcnt(0)" ::: "memory");
}

constexpr int CONV_ITEMS = 257 * 384;
__device__ __forceinline__ void conv_decode(int it, const float* const* in, unsigned char* W13t8, unsigned char* W2t8, const float*& src, int& N, unsigned char*& dst, int& Kb, float& sc) {
    int e, r;
    if (it < 257 * 128) { e = 256 - it / 128; r = 256 + it % 128; } else { const int j = it - 257 * 128; e = 256 - j / 256; r = j % 256; }
    if (r < 256) { const int w3 = r >> 7, rr = r & 127, kb = ((rr >> 4) << 1) | (rr & 1), nb = (rr >> 1) & 7, n0 = nb * 32;
        const float* W = (e < 256) ? in[w3 ? 32 : 31] + (size_t)e * D * FF : in[w3 ? 35 : 34];
        const int drow = 256 * (n0 >> 7) + (n0 & 127) + 128 * w3;
        src = W + (size_t)kb * 64 * FF + n0; N = FF; dst = W13t8 + ((size_t)e * 512 + drow) * D + kb * 64; Kb = D; sc = 128.f; }
    else { const int rr = r - 256, kb = rr & 3, nb = rr >> 2;
        const float* W = (e < 256) ? in[33] + (size_t)e * FF * D : in[36];
        src = W + (size_t)kb * 64 * D + nb * 32; N = D; dst = W2t8 + ((size_t)e * D + nb * 32) * FF + kb * 64; Kb = FF; sc = 16.f; }
}

typedef f32x4 AccT[2][2][4][2];
__device__ __forceinline__ u32x4 pack8(const f32x4 a, const f32x4 b) { u32x4 w; w.x = pk2(a[0], a[1]); w.y = pk2(a[2], a[3]); w.z = pk2(b[0], b[1]); w.w = pk2(b[2], b[3]); return w; }
__device__ __forceinline__ void unpack8(const u32x4 w, f32x4& a, f32x4& b) { a = (f32x4){bflo(w.x), bfhi(w.x), bflo(w.y), bfhi(w.y)}; b = (f32x4){bflo(w.z), bfhi(w.z), bflo(w.w), bfhi(w.w)}; }
__device__ __forceinline__ f32x4 sig4(const f32x4 v) { return (f32x4){sigmoidf_(v[0]), sigmoidf_(v[1]), sigmoidf_(v[2]), sigmoidf_(v[3])}; }
__device__ __forceinline__ f32x4 sigs4(const f32x4 v, const float c) { f32x4 r;
#pragma unroll
    for (int q = 0; q < 4; ++q) r[q] = frcp(1.f + fexp2(c * v[q]));
    return r; }
struct EpiInProj { static constexpr bool PERM = true; bf16_t* projA; bf16_t* gates; float* ssq;
    __device__ __forceinline__ void operator()(const AccT& acc, const pg8::Unit& u, int wr, int wc, int fr, int fq) const {
        asm volatile("" : "+v"(fr), "+v"(fq), "+s"(wr), "+s"(wc));
        constexpr float SC = 1.f / 512.f;
#pragma unroll
        for (int ai = 0; ai < 2; ++ai)
#pragma unroll
            for (int m = 0; m < 4; ++m) { const int row = u.pm * 256 + ai * 128 + wr * 64 + m * 16 + fr;
#pragma unroll
                for (int bj = 0; bj < 2; ++bj) { const int col = u.pn * 256 + bj * 128 + wc * 32 + 8 * fq;
                    if (col < PAW) *(u32x4*)(projA + (size_t)row * PAW + col) = pack8(acc[ai][bj][m][0] * SC, acc[ai][bj][m][1] * SC);
                    else if (col < INW && row < NL) *(u32x4*)(gates + (size_t)row * GW + (col - PAW)) = pack8(sigs4(acc[ai][bj][m][0], -1.4426950408889634f * SC), sigs4(acc[ai][bj][m][1], -1.4426950408889634f * SC)); }
                if (u.pn <= 1) {
                    float s0 = 0.f, s1 = 0.f;
#pragma unroll
                    for (int n = 0; n < 2; ++n)
#pragma unroll
                        for (int q = 0; q < 4; ++q) { s0 += acc[ai][0][m][n][q] * acc[ai][0][m][n][q]; s1 += acc[ai][1][m][n][q] * acc[ai][1][m][n][q]; }
                    s0 += __shfl_xor(s0, 16, 64); s0 += __shfl_xor(s0, 32, 64); s1 += __shfl_xor(s1, 16, 64); s1 += __shfl_xor(s1, 32, 64);
                    s0 *= SC * SC; s1 *= SC * SC;
                    if (fq == 0) { if (u.pn == 0) ssq[(size_t)row * 12 + wc] = s0 + s1; else { ssq[(size_t)row * 12 + 4 + wc] = s0; if (wc == 0) ssq[(size_t)row * 12 + 8] = s1; } }
                } } } };
struct EpiMerge { static constexpr bool PERM = true; const bf16_t* gates; bf16_t* merged; unsigned char* merged8;
    __device__ __forceinline__ void operator()(const AccT& acc, const pg8::Unit& u, int wr, int wc, int fr, int fq) const {
        asm volatile("" : "+v"(fr), "+v"(fq), "+s"(wr), "+s"(wc));
        if (u.k) asm volatile("s_waitcnt vmcnt(0)" ::: "memory");
        constexpr float SC = 1.f / 512.f;
        const int c0 = (u.pn & 3) * 256 + wc * 32 + 8 * fq;
        const size_t rbase = (size_t)(u.pm * 256 + wr * 64 + fr);
        u32x4 gc[2], gn[2], pc[2] = {(u32x4){0u, 0u, 0u, 0u}, (u32x4){0u, 0u, 0u, 0u}}, pn2[2] = {(u32x4){0u, 0u, 0u, 0u}, (u32x4){0u, 0u, 0u, 0u}};
#pragma unroll
        for (int bj = 0; bj < 2; ++bj) { gc[bj] = *(const u32x4*)(gates + rbase * GW + (u.k ? 1024 : 0) + c0 + bj * 128); if (u.k) pc[bj] = *(const u32x4*)(merged + rbase * D + c0 + bj * 128); }
#pragma unroll
        for (int it = 0; it < 8; ++it) { const int ai = it >> 2, m = it & 3;
            const size_t row = rbase + ai * 128 + m * 16;
            if (it < 7) { const size_t row2 = rbase + ((it + 1) >> 2) * 128 + ((it + 1) & 3) * 16;
#pragma unroll
                for (int bj = 0; bj < 2; ++bj) { gn[bj] = *(const u32x4*)(gates + row2 * GW + (u.k ? 1024 : 0) + c0 + bj * 128); if (u.k) pn2[bj] = *(const u32x4*)(merged + row2 * D + c0 + bj * 128); } }
#pragma unroll
            for (int bj = 0; bj < 2; ++bj) {
                f32x4 g0, g1; unpack8(gc[bj], g0, g1);
                f32x4 o0 = g0 * SC * acc[ai][bj][m][0], o1 = g1 * SC * acc[ai][bj][m][1];
                if (u.k) { f32x4 p0, p1; unpack8(pc[bj], p0, p1); o0 = o0 + p0; o1 = o1 + p1;
                    float e8[8];
#pragma unroll
                    for (int q = 0; q < 4; ++q) { e8[q] = fminf(fmaxf(16.f * o0[q], -448.f), 448.f); e8[4 + q] = fminf(fmaxf(16.f * o1[q], -448.f), 448.f); }
                    int wlo = __builtin_amdgcn_cvt_pk_fp8_f32(e8[0], e8[1], 0, false); wlo = __builtin_amdgcn_cvt_pk_fp8_f32(e8[2], e8[3], wlo, true);
                    int whi = __builtin_amdgcn_cvt_pk_fp8_f32(e8[4], e8[5], 0, false); whi = __builtin_amdgcn_cvt_pk_fp8_f32(e8[6], e8[7], whi, true);
                    *(u32x2*)(merged8 + row * D + c0 + bj * 128) = (u32x2){(unsigned)wlo, (unsigned)whi}; }
                else *(u32x4*)(merged + row * D + c0 + bj * 128) = pack8(o0, o1);
                gc[bj] = gn[bj]; pc[bj] = pn2[bj]; } } } };
struct EpiOut { static constexpr bool PERM = false; const float* x; const float* mod; float* out;
    __device__ __forceinline__ void operator()(const AccT& acc, const pg8::Unit& u, int wr, int wc, int fr, int fq) const {
        asm volatile("" : "+v"(fr), "+v"(fq), "+s"(wr), "+s"(wc));
        const float* ga = mod + ((u.pm * 256) >> 11) * 6144 + 2048 + u.pn * 256 + wc * 32 + 4 * fq;
        f32x4 g[2][2];
#pragma unroll
        for (int bj = 0; bj < 2; ++bj)
#pragma unroll
            for (int n = 0; n < 2; ++n) g[bj][n] = *(const f32x4*)(ga + bj * 128 + 16 * n) * (1.f / 2048.f);
        const size_t base = (size_t)(u.pm * 256 + wr * 64 + fr) * D + u.pn * 256 + wc * 32 + 4 * fq;
        f32x4 xc[2][2], xn[2][2];
#pragma unroll
        for (int bj = 0; bj < 2; ++bj)
#pragma unroll
            for (int n = 0; n < 2; ++n) xc[bj][n] = *(const f32x4*)(x + base + bj * 128 + 16 * n);
#pragma unroll
        for (int it = 0; it < 8; ++it) { const int ai = it >> 2, m = it & 3;
            const size_t o = base + (size_t)(ai * 128 + m * 16) * D;
            if (it < 7) { const size_t o2 = base + (size_t)(((it + 1) >> 2) * 128 + ((it + 1) & 3) * 16) * D;
#pragma unroll
                for (int bj = 0; bj < 2; ++bj)
#pragma unroll
                    for (int n = 0; n < 2; ++n) xn[bj][n] = *(const f32x4*)(x + o2 + bj * 128 + 16 * n); }
#pragma unroll
            for (int bj = 0; bj < 2; ++bj)
#pragma unroll
                for (int n = 0; n < 2; ++n) { *(f32x4*)(out + o + bj * 128 + 16 * n) = xc[bj][n] + g[bj][n] * acc[ai][bj][m][n]; xc[bj][n] = xn[bj][n]; } } } };
struct EpiRouter { static constexpr bool PERM = false; float* scores;
    __device__ __forceinline__ void operator()(const AccT& acc, const pg8::Unit& u, int wr, int wc, int fr, int fq) const {
        asm volatile("" : "+v"(fr), "+v"(fq), "+s"(wr), "+s"(wc));
#pragma unroll
        for (int ai = 0; ai < 2; ++ai)
#pragma unroll
            for (int m = 0; m < 4; ++m) { const int row = u.pm * 256 + ai * 128 + wr * 64 + m * 16 + fr;
#pragma unroll
                for (int bj = 0; bj < 2; ++bj)
#pragma unroll
                    for (int n = 0; n < 2; ++n) { const int c = bj * 128 + wc * 32 + 16 * n + 4 * fq; *(f32x4*)(scores + (size_t)row * 256 + c) = sig4(acc[ai][bj][m][n]); } } } };
struct EpiUp { static constexpr bool PERM = true; unsigned char* hb;
    __device__ __forceinline__ void operator()(const AccT& acc, const pg8::Unit& u, int wr, int wc, int fr, int fq) const {
        asm volatile("" : "+v"(fr), "+v"(fq), "+s"(wr), "+s"(wc));
#pragma unroll
        for (int ai = 0; ai < 2; ++ai)
#pragma unroll
            for (int m = 0; m < 4; ++m) { const int rl = ai * 128 + wr * 64 + m * 16 + fr;
                if (u.pm * 256 + rl < u.cnt) {
                    f32x4 h0, h1;
#pragma unroll
                    for (int q = 0; q < 4; ++q) { const float a0 = acc[ai][0][m][0][q], a1 = acc[ai][0][m][1][q];
                        h0[q] = fminf(fmaxf((1.f / 131072.f) * a0 * frcp(1.f + fexp2(-1.4426950408889634f / 512.f * a0)) * acc[ai][1][m][0][q], -448.f), 448.f);
                        h1[q] = fminf(fmaxf((1.f / 131072.f) * a1 * frcp(1.f + fexp2(-1.4426950408889634f / 512.f * a1)) * acc[ai][1][m][1][q], -448.f), 448.f); }
                    int lo = __builtin_amdgcn_cvt_pk_fp8_f32(h0[0], h0[1], 0, false); lo = __builtin_amdgcn_cvt_pk_fp8_f32(h0[2], h0[3], lo, true);
                    int hi = __builtin_amdgcn_cvt_pk_fp8_f32(h1[0], h1[1], 0, false); hi = __builtin_amdgcn_cvt_pk_fp8_f32(h1[2], h1[3], hi, true);
                    *(u32x2*)(hb + (size_t)(u.s0 + rl) * FF + u.k * 128 + wc * 32 + 8 * fq) = (u32x2){(unsigned)lo, (unsigned)hi}; } } } };
struct EpiDown { static constexpr bool PERM = true; unsigned char* yb;
    __device__ __forceinline__ void operator()(const AccT& acc, const pg8::Unit& u, int wr, int wc, int fr, int fq) const {
        asm volatile("" : "+v"(fr), "+v"(fq), "+s"(wr), "+s"(wc));
#pragma unroll
        for (int ai = 0; ai < 2; ++ai)
#pragma unroll
            for (int m = 0; m < 4; ++m) { const int rl = ai * 128 + wr * 64 + m * 16 + fr;
                if (u.pm * 256 + rl < u.cnt) {
                    u32x4 w;
#pragma unroll
                    for (int bj = 0; bj < 2; ++bj) { const f32x4 a = acc[ai][bj][m][0], b = acc[ai][bj][m][1];
                        int lo = __builtin_amdgcn_cvt_pk_fp8_f32(a[0], a[1], 0, false); lo = __builtin_amdgcn_cvt_pk_fp8_f32(a[2], a[3], lo, true);
                        int hi = __builtin_amdgcn_cvt_pk_fp8_f32(b[0], b[1], 0, false); hi = __builtin_amdgcn_cvt_pk_fp8_f32(b[2], b[3], hi, true);
                        if (bj == 0) { w.x = (unsigned)lo; w.y = (unsigned)hi; } else { w.z = (unsigned)lo; w.w = (unsigned)hi; } }
                    *(u32x4*)(yb + (size_t)(u.s0 + rl) * D + u.k * 256 + wc * 64 + fq * 16) = w; } } } };

struct EpiQKV { static constexpr bool PERM = true; const float* ssq; bf16_t* qraw; bf16_t* kvraw;
    __device__ __forceinline__ void operator()(const AccT& acc, const pg8::Unit& u, int wr, int wc, int fr, int fq) const {
        asm volatile("" : "+v"(fr), "+v"(fq), "+s"(wr), "+s"(wc));
        f32x4 sq8[8];
#pragma unroll
        for (int it = 0; it < 8; ++it) sq8[it] = *(const f32x4*)(ssq + (size_t)(u.pm * 256 + (it >> 2) * 128 + wr * 64 + (it & 3) * 16 + fr) * 12 + (u.k ? 4 : 0));
#pragma unroll
        for (int ai = 0; ai < 2; ++ai)
#pragma unroll
            for (int m = 0; m < 4; ++m) { const int row = u.pm * 256 + ai * 128 + wr * 64 + m * 16 + fr;
                const f32x4 sq = sq8[ai * 4 + m];
                const float rstd = rsqrtf((sq[0] + sq[1] + sq[2] + sq[3]) * (u.k ? (1.f / 128.f) : (1.f / 256.f)) + EPS);
                bf16_t* d = u.k ? kvraw + (size_t)row * 1024 + (u.pn - 3) * 256 : qraw + (size_t)row * 768 + u.pn * 256;
#pragma unroll
                for (int bj = 0; bj < 2; ++bj) *(u32x4*)(d + bj * 128 + wc * 32 + 8 * fq) = pack8(acc[ai][bj][m][0] * rstd, acc[ai][bj][m][1] * rstd);
                asm volatile("" ::: "memory"); } } };
struct EpiP4 { static constexpr bool PERM = true; bf16_t* zbuf; bf16_t* gbuf; const float* w0; const float* a0;
    __device__ __forceinline__ void operator()(const AccT& acc, const pg8::Unit& u, int wr, int wc, int fr, int fq) const {
        asm volatile("" : "+v"(fr), "+v"(fq), "+s"(wr), "+s"(wc));
        f32x4 bs[2][2];
        { const int c_ = (u.pn >> 2) * 512 + (u.pn & 3) * 128 + wc * 32 + 8 * fq;
          const float* p0_ = u.k ? w0 : w0 + c_; const float* p1_ = u.k ? a0 : a0 + c_;
          bs[0][0] = *(const f32x4*)p0_; bs[0][1] = *(const f32x4*)(p0_ + 4); bs[1][0] = *(const f32x4*)p1_; bs[1][1] = *(const f32x4*)(p1_ + 4); }
#pragma unroll
        for (int ai = 0; ai < 2; ++ai)
#pragma unroll
            for (int m = 0; m < 4; ++m) { const int row = u.pm * 256 + ai * 128 + wr * 64 + m * 16 + fr;
#pragma unroll
                for (int bj = 0; bj < 2; ++bj) {
                    bf16_t* d = u.k ? gbuf + (size_t)row * 512 + (u.pn - 8) * 256 + bj * 128 : zbuf + ((size_t)(u.pn >> 2) * NT + row) * 1024 + bj * 512 + (u.pn & 3) * 128;
                    f32x4 v0 = acc[ai][bj][m][0], v1 = acc[ai][bj][m][1];
                    if (!u.k) { v0 = sig4(v0 + bs[bj][0]); v1 = sig4(v1 + bs[bj][1]); }
                    *(u32x4*)(d + wc * 32 + 8 * fq) = pack8(v0, v1); }
                asm volatile("" ::: "memory"); } } };

constexpr int NCHUNK = KEYS / 32;
typedef short v4i16_t __attribute__((ext_vector_type(4)));

struct Args { const float* in[37]; float* out; unsigned char* ws; int ph_lo, ph_hi; };
constexpr int LDS_BYTES = 160 * 1024;
constexpr int LDS_MISC = 159 * 1024;
constexpr int LDS_EOFF = 148 * 1024;


__global__ void __launch_bounds__(NTHREADS, 2) fwd_kernel(Args args) {
    extern __shared__ __attribute__((aligned(16))) unsigned char lds_raw[];
    LAS unsigned char* lds = (LAS unsigned char*)lds_raw;
    const int tid = threadIdx.x, lane = tid & 63, wave = __builtin_amdgcn_readfirstlane(tid >> 6), wm = wave >> 1, wn = wave & 1, hh = lane >> 5, l31 = lane & 31;
    const int G = gridDim.x, bid = blockIdx.x;
    const int vcu = (G % 8 == 0) ? (bid % 8) * (G / 8) + bid / 8 : bid;
    unsigned char* ws = args.ws;
    unsigned* ctl = (unsigned*)(ws + WS_CTL);
    const int lo = args.ph_lo, hi = args.ph_hi;

    if (tid < 4) ((LAS unsigned*)(lds + LDS_MISC))[tid] = 0u;
    __syncthreads();
#if MK_ONE_LAUNCH
    XcdBarrier bar = xcd_barrier_post(ctl + CW_BAR, (volatile LAS unsigned*)(lds + LDS_MISC));
#define GRID_BAR() xcd_barrier(bar)
#else
#define GRID_BAR() do {} while (0)
#endif
#define IN(k) (lo <= (k) && (k) < hi)
#define BOTH(k) (IN(k) && IN((k) + 1))

    const float* x_in = args.in[0]; const float* ctx_in = args.in[2];
    float* mod = (float*)(ws + WS_MOD);
    float* ropec = (float*)(ws + WS_ROPE); float* ropes = ropec + SEQ * 16;
    unsigned char* h8 = ws + WS_H;
    bf16_t* projA = (bf16_t*)(ws + WS_PA);
    bf16_t* gates = (bf16_t*)(ws + WS_GATES);
    bf16_t* qraw = (bf16_t*)(ws + WS_QRAW);
    bf16_t* Kb = (bf16_t*)(ws + WS_K);
    bf16_t* Vt = (bf16_t*)(ws + WS_VT);
    unsigned char* att8 = ws + WS_ATT;
    bf16_t* rbuf = (bf16_t*)(ws + WS_R);
    bf16_t* kbuf = (bf16_t*)(ws + WS_KB);
    bf16_t* vbuf = (bf16_t*)(ws + WS_V);
    bf16_t* kkbuf = (bf16_t*)(ws + WS_KK);
    bf16_t* loraA = (bf16_t*)(ws + WS_LORA);
    bf16_t* gateA = (bf16_t*)(ws + WS_GATEA);
    bf16_t* kvraw = (bf16_t*)(ws + WS_KD);
    bf16_t* gbuf = (bf16_t*)(ws + WS_BB);
    bf16_t* zbuf = (bf16_t*)(ws + WS_WB);
    bf16_t* ybuf = (bf16_t*)(ws + WS_Y);
    unsigned char* rwout8 = ws + WS_RWOUT;
    bf16_t* merged = (bf16_t*)(ws + WS_MERGED);
    unsigned char* merged8 = ws + WS_Y;
    unsigned char* Win_t8 = ws + WS_WIN_T; unsigned char* Wo_t8 = ws + WS_WO_T; unsigned char* Wout_t8 = ws + WS_WOUT_T; bf16_t* Wr_t = (bf16_t*)(ws + WS_WR_T);
    unsigned char* W13t8 = ws + WS_W13T; unsigned char* W2t8 = ws + WS_W2T;
    bf16_t* Wqkv_t = (bf16_t*)(ws + WS_WQKV_T); bf16_t* Wlora_t = (bf16_t*)(ws + WS_WLORA_T); bf16_t* Wg2_t = (bf16_t*)(ws + WS_WG2_T); float* ssq = (float*)(ws + WS_SSQ);

    const int k256 = 256 + (lo >> 20);

    if (IN(0)) {
        if (bid < 192) {
            const int cg = bid % 96, kh = bid / 96;
            LAS float* sl = (LAS float*)lds;
            const float* c = args.in[1]; const float* cc = args.in[3];
            for (int i = tid; i < 17 * 512; i += NTHREADS) { const int r = i >> 9, k = kh * 512 + (i & 511); const float v = (r < 16) ? c[r * 1024 + k] : cc[k]; sl[i] = v * sigmoidf_(v); }
            __syncthreads();
            const float* aw = args.in[4];
            const int col = cg * 64 + lane;
            float a17[17];
#pragma unroll
            for (int r = 0; r < 17; ++r) a17[r] = 0.f;
#pragma unroll 8
            for (int k = wave * 64; k < wave * 64 + 64; ++k) {
                const float wv = aw[(size_t)(kh * 512 + k) * 6144 + col];
#pragma unroll
                for (int r = 0; r < 17; ++r) a17[r] += sl[r * 512 + k] * wv;
            }
            __syncthreads();
            LAS float* red = (LAS float*)(lds + 40 * 1024);
#pragma unroll
            for (int r = 0; r < 17; ++r) red[(wave * 17 + r) * 64 + lane] = a17[r];
            __syncthreads();
            for (int i = tid; i < 17 * 64; i += NTHREADS) {
                const int r = i >> 6, cl = i & 63; float s = 0.f;
#pragma unroll
                for (int w = 0; w < 8; ++w) s += red[(w * 17 + r) * 64 + cl];
                if (kh == 0) s += args.in[5][cg * 64 + cl];
                atomicAdd(&mod[r * 6144 + cg * 64 + cl], s);
            }
        } else {
            const int i = (bid - 192) * NTHREADS + tid;
            if (i < SEQ * 16) {
                const int t = i >> 4, j = i & 15;
                const float pos = (j < 8) ? (float)(t >> 6) : (float)(t & 63);
                const float inv = powf(10000.f, -(float)(j & 7) / 8.f);
                const float ang = pos * inv;
                ropec[i] = cosf(ang); ropes[i] = sinf(ang);
            }
        }
        __syncthreads();
        {
            LAS float* scr = (LAS float*)(lds + wave * 8448);
            for (int it = vcu * 8 + wave; it < 3232; it += G * 8) {
                const float* Ws; int Nn; unsigned char* dd; int Kb; float sc = 128.f;
                if (it < 2208) { const int kbp = it / 276, rem = it % 276, nb = rem >> 1, kb = 2 * kbp + (rem & 1);
                    Ws = args.in[8] + (size_t)kb * 64 * INW + nb * 32; Nn = INW; dd = Win_t8 + (size_t)nb * 32 * D + kb * 64; Kb = D; }
                else if (it < 2720) { const int r = (it - 2208) & 255, which = (it - 2208) >> 8, nb = r >> 3, kb = r & 7;
                    Ws = args.in[which ? 27 : 16] + (size_t)kb * 64 * D + nb * 32; Nn = D; dd = Wo_t8 + (size_t)which * D * 512 + (size_t)nb * 32 * 512 + kb * 64; Kb = 512; sc = 64.f; }
                else { const int r = it - 2720, nb = r >> 4, kb = r & 15; Ws = args.in[28] + (size_t)kb * 64 * D + nb * 32; Nn = D; dd = Wout_t8 + (size_t)nb * 32 * D + kb * 64; Kb = D; }
                transpose_block_f8(Ws, Nn, dd, Kb, scr, lane, sc);
            }
            for (int it = 3232 + vcu * 8 + wave; it < 3360 + 96 + 128 + 256 + 64; it += G * 8) {
                const float* Ws; int Nn; int kval = 64; const float* ksc = nullptr; bf16_t* dd; int Kk;
                if (it < 3360) { const int r = it - 3232, kb = r >> 3, nb = r & 7; Ws = args.in[29] + (size_t)kb * 64 * 256 + nb * 32; Nn = 256; dd = Wr_t + (size_t)nb * 32 * D + kb * 64; Kk = D; }
                else {
                    int r = it - 3360; Kk = 256;
                    if (r < 96) {
                        const int kb = r / 24, nb = r % 24;
                        Ws = args.in[11] + (size_t)kb * 64 * 768 + nb * 32; Nn = 768; ksc = args.in[10] + kb * 64; dd = Wqkv_t + (size_t)nb * 32 * 256 + kb * 64;
                    } else if (r < 224) {
                        r -= 96; const int kb = r >> 5, nb = r & 31;
                        dd = Wqkv_t + (size_t)768 * 256 + (size_t)nb * 32 * 256 + kb * 64;
                        Ws = args.in[13] + (size_t)(kb & 1) * 64 * 1024 + nb * 32; Nn = 1024; ksc = args.in[12] + (kb & 1) * 64; if (kb >= 2) kval = 0;
                    } else if (r < 480) {
                        r -= 224; const int kb = r >> 6, rr = r & 63, dir = rr >> 5, isa = (rr >> 4) & 1, nb = rr & 15;
                        dd = Wlora_t + (size_t)((dir * 4 + (nb >> 2)) * 256 + isa * 128 + (nb & 3) * 32) * 256 + kb * 64;
                        Ws = args.in[isa ? 20 : 18] + (size_t)dir * 64 * 512 + nb * 32; Nn = 512; if (kb != isa * 2 + dir) kval = 0;
                    } else {
                        r -= 480; const int kb = r >> 4, nb = r & 15;
                        dd = Wg2_t + (size_t)nb * 32 * 256 + kb * 64;
                        Ws = args.in[26] + (size_t)(kb < 3 ? kb : 0) * 64 * 512 + nb * 32; Nn = 512; kval = (kb == 2) ? 32 : (kb < 2 ? 64 : 0);
                    }
                }
                transpose_block_ex(Ws, Nn, kval, ksc, dd, Kk, scr, lane);
            }
        }
        if (BOTH(0)) GRID_BAR();
    }

    if (IN(1)) {
        const float* nmix = args.in[6];
        for (int row = bid * 8 + wave; row < NT; row += G * 8) {
            const float* xr = (row < NL) ? x_in + (size_t)row * D : ctx_in + (size_t)(row - NL) * D;
            const int b = (row < NL) ? (row >> 11) : 16;
            const float* mrow = mod + b * 6144;
            f32x4 v[4]; float ss = 0.f;
#pragma unroll
            for (int i = 0; i < 4; ++i) { v[i] = *(const f32x4*)(xr + lane * 4 + 256 * i); ss += v[i][0] * v[i][0] + v[i][1] * v[i][1] + v[i][2] * v[i][2] + v[i][3] * v[i][3]; }
            ss = wave_sum(ss);
            const float rstd = rsqrtf(ss * (1.f / D) + EPS);
#pragma unroll
            for (int i = 0; i < 4; ++i) {
                const int c = lane * 4 + 256 * i;
                const f32x4 g = *(const f32x4*)(nmix + c), sh = *(const f32x4*)(mrow + c), sc = *(const f32x4*)(mrow + 1024 + c);
                f32x4 y = v[i] * rstd * g * (sc + 1.f) + sh;
#pragma unroll
                for (int q = 0; q < 4; ++q) y[q] = fminf(fmaxf(4.f * y[q], -448.f), 448.f);
                int w8 = __builtin_amdgcn_cvt_pk_fp8_f32(y[0], y[1], 0, false); w8 = __builtin_amdgcn_cvt_pk_fp8_f32(y[2], y[3], w8, true);
                *(int*)(h8 + (size_t)row * D + c) = w8;
            }
        }
        if (BOTH(1)) GRID_BAR();
    }

    if (IN(2)) {
        pg8::SchedInProj S{vcu, G}; EpiInProj E{projA, gates, ssq}; pg8::APlain AO;
        pg8::gemm_phase<EpiInProj, pg8::SchedInProj, pg8::APlain, true, true>(lds, (const char*)h8, (const char*)Win_t8, 2 * k256, S, E, AO);
        if (BOTH(2)) GRID_BAR();
    }

    if (IN(3)) {
        const bool split3 = (G == 256);
        const int xj = bid >> 3, xx = bid & 7;
        const int ga3 = split3 ? 192 : G, gi3 = split3 ? (xj < 24 ? xx * 24 + xj : -1) : vcu, ei3 = split3 ? (xj >= 24 ? xx * 8 + (xj - 24) : -1) : -1;
        if (gi3 >= 0) {
            pg8::SchedQKV S{gi3, ga3}; EpiQKV E{ssq, qraw, kvraw}; pg8::AProj AO;
            pg8::gemm_phase<EpiQKV, pg8::SchedQKV, pg8::AProj, true, false, true>(lds, (const char*)projA, (const char*)Wqkv_t, k256, S, E, AO);
        }
        {
            const float* cw = args.in[9]; const float* k_k = args.in[21];
            const int sub = tid >> 8, ch = tid & 255, c0 = ch * 8;
            if (ch < 244) {
                float w0[8], w1[8], w2[8], kkw[8];
#pragma unroll
                for (int j = 0; j < 8; ++j) { w0[j] = cw[c0 + j]; w1[j] = cw[1952 + c0 + j]; w2[j] = cw[2 * 1952 + c0 + j]; kkw[j] = (c0 >= 512 && c0 < 1024) ? k_k[c0 - 512 + j] : 0.f; }
                const int n1 = split3 ? (NT / 16) * 3 / 4 : 0;
                for (int pass = 0; pass < 2; ++pass) {
                const int ifirst = pass == 0 ? ei3 : n1 + vcu, istep = pass == 0 ? 64 : G, ilim = pass == 0 ? (ei3 >= 0 ? n1 : 0) : NT / 16;
                if (ifirst >= 0)
                for (int item = ifirst; item < ilim; item += istep) {
                    const int tok0 = item * 16 + sub * 8;
                    const bool lat = tok0 < NL;
                    const int tpos0 = lat ? (tok0 & 2047) : ((tok0 - NL) & 255);
                    const int tlen = lat ? SEQ : CTX;
                    const bf16_t* pc = projA + (size_t)tok0 * PAW + RW0 + c0;
                    u32x4 rw[10];
#pragma unroll
                    for (int i = 0; i < 10; ++i) { const int t = tpos0 + i - 1; rw[i] = (t >= 0 && t < tlen) ? *(const u32x4*)(pc + (ptrdiff_t)(i - 1) * PAW) : (u32x4){0u, 0u, 0u, 0u}; }
#pragma unroll
                    for (int tt = 0; tt < 8; ++tt) {
                        const int tok = tok0 + tt;
                        f32x4 pa, pb, ca, cb, na, nb; unpack8(rw[tt], pa, pb); unpack8(rw[tt + 1], ca, cb); unpack8(rw[tt + 2], na, nb);
                        float o[8];
#pragma unroll
                        for (int j = 0; j < 4; ++j) { o[j] = pa[j] * w0[j] + ca[j] * w1[j] + na[j] * w2[j]; o[4 + j] = pb[j] * w0[4 + j] + cb[j] * w1[4 + j] + nb[j] * w2[4 + j]; }
                        u32x4 ov;
                        if (c0 < 1536) {
                            ov.x = pk2(o[0], o[1]); ov.y = pk2(o[2], o[3]); ov.z = pk2(o[4], o[5]); ov.w = pk2(o[6], o[7]);
                            bf16_t* dst = (c0 < 512) ? rbuf : (c0 < 1024 ? kbuf : vbuf);
                            *(u32x4*)(dst + (size_t)tok * 512 + (c0 & 511)) = ov;
                            if (c0 >= 512 && c0 < 1024) {
                                float q[8]; float ss = 0.f;
#pragma unroll
                                for (int j = 0; j < 8; ++j) { q[j] = o[j] * kkw[j]; ss += q[j] * q[j]; }
                                ss += dpp_f<0xB1>(ss); ss += dpp_f<0x4E>(ss); ss += dpp_f<0x141>(ss);
                                const float rn = rsqrtf(ss + 1e-12f);
                                u32x4 kv; kv.x = pk2(q[0] * rn, q[1] * rn); kv.y = pk2(q[2] * rn, q[3] * rn); kv.z = pk2(q[4] * rn, q[5] * rn); kv.w = pk2(q[6] * rn, q[7] * rn);
                                *(u32x4*)(kkbuf + (size_t)tok * 512 + (c0 - 512)) = kv;
                            }
                        } else if (c0 < 1792) {
                            if (c0 < 1664) {
#pragma unroll
                                for (int j = 0; j < 8; ++j) { const float e2 = fexp(2.f * o[j]); o[j] = 1.f - 2.f * frcp(e2 + 1.f); }
                            }
                            ov.x = pk2(o[0], o[1]); ov.y = pk2(o[2], o[3]); ov.z = pk2(o[4], o[5]); ov.w = pk2(o[6], o[7]);
                            *(u32x4*)(loraA + (size_t)tok * 256 + (c0 - 1536)) = ov;
                        } else if (lat) {
#pragma unroll
                            for (int j = 0; j < 8; ++j) o[j] = sigmoidf_(o[j]);
                            ov.x = pk2(o[0], o[1]); ov.y = pk2(o[2], o[3]); ov.z = pk2(o[4], o[5]); ov.w = pk2(o[6], o[7]);
                            *(u32x4*)(gateA + (size_t)tok * 256 + (c0 - 1792)) = ov;
                            if (ch >= 232) *(u32x4*)(gateA + (size_t)tok * 256 + 160 + (ch - 232) * 8) = (u32x4){0u, 0u, 0u, 0u};
                        }
                    }
                }
                }
            }
        }
        if (BOTH(3)) GRID_BAR();
    }

    if (IN(4)) {
        {
            pg8::SchedP4 S{vcu, G}; EpiP4 E{zbuf, gbuf, args.in[17], args.in[19]}; pg8::ATwo AO{(unsigned)((const char*)gateA - (const char*)loraA)};
            pg8::gemm_phase<EpiP4, pg8::SchedP4, pg8::ATwo, true, false, true>(lds, (const char*)loraA, (const char*)Wlora_t, k256, S, E, AO);
        }
        {
            const float* knorm = args.in[15];
            LAS bf16_t* vt = (LAS bf16_t*)lds;
            const int kr_ = tid >> 3, c8 = tid & 7;
            const f32x4 kn0 = *(const f32x4*)(knorm + c8 * 8), kn1 = *(const f32x4*)(knorm + c8 * 8 + 4);
            const int j0 = 8 * (c8 & 1);
            const f32x4 kx1a = *(const f32x4*)(knorm + 64 + j0), kx1b = *(const f32x4*)(knorm + 68 + j0), kx2a = *(const f32x4*)(knorm + 80 + j0), kx2b = *(const f32x4*)(knorm + 84 + j0);
            for (int it = vcu; it < (NT / 64) * 4; it += G) {
                const int hp = it & 3, r0 = (it >> 2) * 64, row = r0 + kr_;
                const bool lat = row < NL;
                const int b = lat ? (row >> 11) : ((row - NL) >> 8);
                const int tpos = lat ? (row & 2047) : ((row - NL) & 255);
                const int key = lat ? tpos : SEQ + tpos;
                const bf16_t* src_ = kvraw + (size_t)row * 1024 + hp * 256 + c8 * 8;
                const u32x4 kw0 = *(const u32x4*)src_, vw0 = *(const u32x4*)(src_ + 64), kw1 = *(const u32x4*)(src_ + 128), vw1 = *(const u32x4*)(src_ + 192);
                const float skr = ssq[(size_t)row * 12 + 8];
                f32x4 x1a, x1b, x2a, x2b; f32x4 ca = {1.f, 1.f, 1.f, 1.f}, cb = ca, sa = {0.f, 0.f, 0.f, 0.f}, sb = sa;
                if (c8 < 4) {
                    unpack8(*(const u32x4*)(projA + (size_t)row * PAW + 384 + j0), x1a, x1b); unpack8(*(const u32x4*)(projA + (size_t)row * PAW + 400 + j0), x2a, x2b);
                    if (lat) { ca = *(const f32x4*)(ropec + tpos * 16 + j0); cb = *(const f32x4*)(ropec + tpos * 16 + j0 + 4); sa = *(const f32x4*)(ropes + tpos * 16 + j0); sb = *(const f32x4*)(ropes + tpos * 16 + j0 + 4); }
                }
                __syncthreads();
                *(LAS u32x4*)(vt + kr_ * 72 + c8 * 8) = vw0; *(LAS u32x4*)(vt + 64 * 72 + kr_ * 72 + c8 * 8) = vw1;
#pragma unroll
                for (int hh2 = 0; hh2 < 2; ++hh2) {
                    const int hd = 2 * hp + hh2;
                    f32x4 k0, k1; unpack8(hh2 ? kw1 : kw0, k0, k1);
                    float s2 = k0[0] * k0[0] + k0[1] * k0[1] + k0[2] * k0[2] + k0[3] * k0[3] + k1[0] * k1[0] + k1[1] * k1[1] + k1[2] * k1[2] + k1[3] * k1[3];
                    s2 += dpp_f<0xB1>(s2); s2 += dpp_f<0x4E>(s2); s2 += dpp_f<0x141>(s2);
                    const float rk = rsqrtf((s2 + skr) * (1.f / 96.f) + EPS);
                    bf16_t* kout = Kb + ((size_t)(b * 8 + hd) * KEYS + key) * 96;
                    *(u32x4*)(kout + c8 * 8) = pack8(k0 * rk * kn0, k1 * rk * kn1);
                    if (c8 < 4) {
                        const f32x4 y1a = x1a * rk * kx1a, y1b = x1b * rk * kx1b, y2a = x2a * rk * kx2a, y2b = x2b * rk * kx2b;
                        const f32x4 oa = (c8 < 2) ? (y1a * ca - y2a * sa) : (y1a * sa + y2a * ca), ob = (c8 < 2) ? (y1b * cb - y2b * sb) : (y1b * sb + y2b * cb);
                        *(u32x4*)(kout + 64 + 8 * c8) = pack8(oa, ob);
                    }
                }
                __syncthreads();
                {
                    const int d = tid >> 3, kc = tid & 7;
                    const int kbase = (lat ? (r0 & 2047) : SEQ + ((r0 - NL) & 255)) + (kc >> 1) * 16;
#pragma unroll
                    for (int hh2 = 0; hh2 < 2; ++hh2) {
                        unsigned short e8[8];
#pragma unroll
                        for (int i = 0; i < 8; ++i) e8[i] = vt[hh2 * 64 * 72 + (kc * 8 + i) * 72 + d];
                        bf16_t* vo = Vt + ((size_t)(b * 8 + 2 * hp + hh2) * 64 + d) * KEYS + kbase + 4 * (kc & 1);
                        u32x2 lo2, hi2; lo2.x = e8[0] | ((unsigned)e8[1] << 16); lo2.y = e8[2] | ((unsigned)e8[3] << 16); hi2.x = e8[4] | ((unsigned)e8[5] << 16); hi2.y = e8[6] | ((unsigned)e8[7] << 16);
                        *(u32x2*)vo = lo2; *(u32x2*)(vo + 8) = hi2;
                    }
                }
            }
            __syncthreads();
        }
        if (BOTH(4)) GRID_BAR();
    }

    if (IN(5)) {
        constexpr int KROW = 208, VROW = 144, KTB = 64 * KROW, ASTAGE = KTB + 64 * VROW;
        const float* qnorm = args.in[14];
        const int cwg = bid * 8 + wave, cW = G * 8;
        LAS unsigned char* cbuf = lds + 52 * 1024 + wave * 8448;
        const int cni = 36 * ((NB * 8 * 4) / G);
        const int cR_ = (CONV_ITEMS + cW - 1) / cW, cR = cR_ < cni - 1 ? cR_ : cni - 1;
        int cc = 0;
        for (int u = bid; u < NB * 8 * 4; u += G) {
            int lq_ = lane; asm volatile("" : "+v"(lq_));
            const int l31q = lq_ & 31, hhq = lq_ >> 5;
            const int qb = u & 3, hd = (u >> 2) & 7, b = u >> 5;
            bf16x8 qf[2][6];
            float mshift[2];
#pragma unroll
            for (int qt = 0; qt < 2; ++qt) {
                const int tq = qb * 512 + wave * 64 + qt * 32 + l31q;
                const bf16_t* qp = qraw + ((size_t)b * SEQ + tq) * 768 + hd * 96 + 8 * hhq;
                u32x4 wq[6]; float ss = 0.f;
#pragma unroll
                for (int j = 0; j < 6; ++j) { wq[j] = *(const u32x4*)(qp + 16 * j); f32x4 a, c; unpack8(wq[j], a, c);
                    ss += a[0] * a[0] + a[1] * a[1] + a[2] * a[2] + a[3] * a[3] + c[0] * c[0] + c[1] * c[1] + c[2] * c[2] + c[3] * c[3]; }
                ss += xor32(ss);
                const float rstd = rsqrtf(ss * (1.f / 96.f) + EPS) * QSCALE;
                float qn = 0.f;
#pragma unroll
                for (int j = 0; j < 4; ++j) { f32x4 a, c; unpack8(wq[j], a, c);
                    a = a * rstd * *(const f32x4*)(qnorm + 16 * j + 8 * hhq); c = c * rstd * *(const f32x4*)(qnorm + 16 * j + 8 * hhq + 4);
                    qn += a[0] * a[0] + a[1] * a[1] + a[2] * a[2] + a[3] * a[3] + c[0] * c[0] + c[1] * c[1] + c[2] * c[2] + c[3] * c[3];
                    qf[qt][j] = __builtin_bit_cast(bf16x8, pack8(a, c)); }
                {
                    f32x4 x1a, x1b, x2a, x2b; unpack8(wq[4], x1a, x1b); unpack8(wq[5], x2a, x2b);
                    x1a = x1a * rstd * *(const f32x4*)(qnorm + 64 + 8 * hhq); x1b = x1b * rstd * *(const f32x4*)(qnorm + 68 + 8 * hhq);
                    x2a = x2a * rstd * *(const f32x4*)(qnorm + 80 + 8 * hhq); x2b = x2b * rstd * *(const f32x4*)(qnorm + 84 + 8 * hhq);
                    qn += x1a[0] * x1a[0] + x1a[1] * x1a[1] + x1a[2] * x1a[2] + x1a[3] * x1a[3] + x1b[0] * x1b[0] + x1b[1] * x1b[1] + x1b[2] * x1b[2] + x1b[3] * x1b[3]
                        + x2a[0] * x2a[0] + x2a[1] * x2a[1] + x2a[2] * x2a[2] + x2a[3] * x2a[3] + x2b[0] * x2b[0] + x2b[1] * x2b[1] + x2b[2] * x2b[2] + x2b[3] * x2b[3];
                    const f32x4 ca = *(const f32x4*)(ropec + tq * 16 + 8 * hhq), cb = *(const f32x4*)(ropec + tq * 16 + 8 * hhq + 4), sa = *(const f32x4*)(ropes + tq * 16 + 8 * hhq), sb = *(const f32x4*)(ropes + tq * 16 + 8 * hhq + 4);
                    qf[qt][4] = __builtin_bit_cast(bf16x8, pack8(x1a * ca - x2a * sa, x1b * cb - x2b * sb));
                    qf[qt][5] = __builtin_bit_cast(bf16x8, pack8(x1a * sa + x2a * ca, x1b * sb + x2b * cb));
                }
                qn += xor32(qn);
                mshift[qt] = sqrtf(qn);
                asm volatile("" :: "v"(qf[qt][0]), "v"(qf[qt][1]), "v"(qf[qt][2]), "v"(qf[qt][3]), "v"(qf[qt][4]), "v"(qf[qt][5]) : "memory");
            }
            float kgmax; { float g_ = (lq_ < 32) ? fmaxf(fmaxf(fabsf(args.in[15][lq_]), fabsf(args.in[15][lq_ + 32])), fabsf(args.in[15][lq_ + 64])) : 0.f;
#pragma unroll
                for (int o_ = 16; o_ >= 1; o_ >>= 1) g_ = fmaxf(g_, __shfl_xor(g_, o_, 64));
                kgmax = __shfl(g_, 0, 64) * 9.797958971f * 1.02f; }
            LAS float* msl = (LAS float*)(lds + 48 * 1024) + wave * 128 + 2 * lq_;
            msl[0] = -mshift[0] * kgmax; msl[1] = -mshift[1] * kgmax;
            const bf16_t* Kg = Kb + (size_t)(b * 8 + hd) * KEYS * 96;
            const bf16_t* Vg = Vt + (size_t)(b * 8 + hd) * 64 * KEYS;
            int tid_ = tid; asm volatile("" : "+v"(tid_));
            const int kc0 = tid_, kc1 = tid_ + 512;
            const int kr0 = kc0 / 12, kh0 = kc0 % 12, kr1 = kc1 / 12, kh1 = kc1 % 12;
            const int vd = tid_ >> 3, vch = tid_ & 7;
            u32x4 pk0, pk1, pvv;
#define ATT_GLOAD(kt) do { pk0 = *(const u32x4*)(Kg + (size_t)((kt) * 64 + kr0) * 96 + kh0 * 8); if (tid < 256) pk1 = *(const u32x4*)(Kg + (size_t)((kt) * 64 + kr1) * 96 + kh1 * 8); \
                pvv = *(const u32x4*)(Vg + (size_t)vd * KEYS + (kt) * 64 + vch * 8); } while (0)
#define ATT_LWRITE(s) do { LAS unsigned char* st_ = lds + (s) * ASTAGE; *(LAS u32x4*)(st_ + kr0 * KROW + kh0 * 16) = pk0; if (tid < 256) *(LAS u32x4*)(st_ + kr1 * KROW + kh1 * 16) = pk1; \
                *(LAS u32x4*)(st_ + KTB + vd * VROW + vch * 16) = pvv; } while (0)
            f32x16 o[2][2];
#pragma unroll
            for (int qt = 0; qt < 2; ++qt)
#pragma unroll
                for (int e2 = 0; e2 < 16; ++e2) { o[qt][0][e2] = 0.f; o[qt][1][e2] = 0.f; }
            float lsum[2] = {0.f, 0.f};
            __syncthreads();
            ATT_GLOAD(0); ATT_LWRITE(0);
            __syncthreads();
            constexpr int NKT = KEYS / 64;
            for (int kt = 0; kt < NKT; ++kt) {
                const bool more = kt + 1 < NKT;
                if (more) ATT_GLOAD(kt + 1);
                {
                    const int ixp = cc > 0 ? ((cc - 1) * cR) / (cni - 1) : 0, ixc = (cc * cR) / (cni - 1), ixn = ((cc + 1) * cR) / (cni - 1);
                    const int itp = ixp * cW + cwg, itn = ixc * cW + cwg;
                    const bool hp = cc > 0 && cc < cni && ixc != ixp && ixp < cR && itp < CONV_ITEMS, hn = cc < cni - 1 && ixn != ixc && ixc < cR && itn < CONV_ITEMS;
                    int lc = lane; asm volatile("" : "+v"(lc));
                    const int nn = lc >> 2, c4 = lc & 3;
                    u32x4 ov[2]; unsigned char* dstp = nullptr; int Kbp = 0;
                    if (hp) {
                        const float* srcp; int Np; float scp;
                        conv_decode(itp, args.in, W13t8, W2t8, srcp, Np, dstp, Kbp, scp);
#pragma unroll
                        for (int j = 0; j < 2; ++j) {
                            const LAS float* sp = (const LAS float*)(cbuf + (2 * c4) * 1024 + c4 * 64 + (nn + 16 * j) * 4);
#pragma unroll
                            for (int q = 0; q < 4; ++q) {
                                const int o_ = ((4 * q) >> 3) * 256 + ((4 * q) & 7) * 32;
                                int w = __builtin_amdgcn_cvt_pk_fp8_f32(sp[o_] * scp, sp[o_ + 32] * scp, 0, false); w = __builtin_amdgcn_cvt_pk_fp8_f32(sp[o_ + 64] * scp, sp[o_ + 96] * scp, w, true); ov[j][q] = (unsigned)w; }
                        }
                    }
                    asm volatile("s_waitcnt lgkmcnt(0)" ::: "memory");
                    if (hn) {
                        const float* srcn; unsigned char* dstn; int Nn, Kbn; float scn;
                        conv_decode(itn, args.in, W13t8, W2t8, srcn, Nn, dstn, Kbn, scn);
                        const float* gp = srcn + (size_t)(lc >> 3) * Nn + (lc & 7) * 4;
#pragma unroll
                        for (int i = 0; i < 8; ++i) __builtin_amdgcn_global_load_lds((const unsigned*)(gp + (size_t)(8 * i) * Nn), (LAS unsigned*)(cbuf + i * 1024 + (i >> 1) * 64), 16, 0, 2);
                    }
                    if (hp) {
#pragma unroll
                        for (int j = 0; j < 2; ++j) *(u32x4*)(dstp + (size_t)(nn + 16 * j) * Kbp + 16 * c4) = ov[j];
                    }
                    ++cc;
                    __builtin_amdgcn_sched_barrier(0);
                }
                LAS unsigned char* st = lds + (kt & 1) * ASTAGE;
                f32x16 s[2][2];
#pragma unroll
                for (int qt = 0; qt < 2; ++qt) { const float ms_ = msl[qt];
#pragma unroll
                    for (int e2 = 0; e2 < 16; ++e2) { s[qt][0][e2] = ms_; s[qt][1][e2] = ms_; } }
#pragma unroll
                for (int k2 = 0; k2 < 2; ++k2)
#pragma unroll
                    for (int j = 0; j < 6; ++j) {
                        const bf16x8 kf = *(LAS bf16x8*)(st + (k2 * 32 + l31q) * KROW + (2 * j + hhq) * 16);
                        s[0][k2] = __builtin_amdgcn_mfma_f32_32x32x16_bf16(kf, qf[0][j], s[0][k2], 0, 0, 0);
                        s[1][k2] = __builtin_amdgcn_mfma_f32_32x32x16_bf16(kf, qf[1][j], s[1][k2], 0, 0, 0);
                    }
#pragma unroll
                for (int qt = 0; qt < 2; ++qt) {
                    if (__builtin_expect(k256 == 0, 0)) {
#pragma unroll
                        for (int e2 = 0; e2 < 16; ++e2) { o[qt][0][e2] *= 0.5f; o[qt][1][e2] *= 0.5f; s[qt][0][e2] -= 1.f; s[qt][1][e2] -= 1.f; }
                        lsum[qt] *= 0.5f;
                    }
                    float ps = 0.f;
#pragma unroll
                    for (int k2 = 0; k2 < 2; ++k2)
#pragma unroll
                        for (int e2 = 0; e2 < 16; ++e2) { s[qt][k2][e2] = fexp2(s[qt][k2][e2]); ps += s[qt][k2][e2]; }
                    lsum[qt] += ps;
#pragma unroll
                    for (int k2 = 0; k2 < 2; ++k2)
#pragma unroll
                        for (int s2 = 0; s2 < 2; ++s2) {
                            u32x4 w; w.x = pk2(s[qt][k2][8 * s2], s[qt][k2][8 * s2 + 1]); w.y = pk2(s[qt][k2][8 * s2 + 2], s[qt][k2][8 * s2 + 3]); w.z = pk2(s[qt][k2][8 * s2 + 4], s[qt][k2][8 * s2 + 5]); w.w = pk2(s[qt][k2][8 * s2 + 6], s[qt][k2][8 * s2 + 7]);
                            const bf16x8 pf = __builtin_bit_cast(bf16x8, w);
#pragma unroll
                            for (int dt = 0; dt < 2; ++dt) {
                                const bf16x8 vf = *(LAS bf16x8*)(st + KTB + (dt * 32 + l31q) * VROW + (k2 * 32 + s2 * 16) * 2 + 16 * hhq);
                                o[qt][dt] = __builtin_amdgcn_mfma_f32_32x32x16_bf16(vf, pf, o[qt][dt], 0, 0, 0);
                            }
                        }
                }
                if (more) ATT_LWRITE((kt + 1) & 1);
                __syncthreads();
            }
#pragma unroll
            for (int qt = 0; qt < 2; ++qt) {
                float ls = lsum[qt];
                { auto rr = __builtin_amdgcn_permlane32_swap(__builtin_bit_cast(unsigned, ls), __builtin_bit_cast(unsigned, ls), false, false); ls = __builtin_bit_cast(float, rr[0]) + __builtin_bit_cast(float, rr[1]); }
                const float inv = frcp(ls);
                unsigned char* op = att8 + ((size_t)b * SEQ + qb * 512 + wave * 64 + qt * 32 + l31q) * 512 + hd * 64;
                const float inv8 = 8.f * inv;
#pragma unroll
                for (int dt = 0; dt < 2; ++dt)
#pragma unroll
                    for (int i4 = 0; i4 < 4; ++i4) {
                        const int d = dt * 32 + 8 * i4 + 4 * hhq;
                        float e4[4];
#pragma unroll
                        for (int q = 0; q < 4; ++q) e4[q] = fminf(fmaxf(o[qt][dt][4 * i4 + q] * inv8, -448.f), 448.f);
                        int w8 = __builtin_amdgcn_cvt_pk_fp8_f32(e4[0], e4[1], 0, false); w8 = __builtin_amdgcn_cvt_pk_fp8_f32(e4[2], e4[3], w8, true);
                        *(int*)(op + d) = w8;
                    }
            }
#undef ATT_GLOAD
#undef ATT_LWRITE
        }
        if (BOTH(5)) GRID_BAR();
    }

#define SCAN_ROW(g) (((g) < CTX) ? (NL + b * CTX + (dir ? (CTX - 1 - (g)) : (g))) : (b * SEQ + (dir ? (SEQ - 1 - ((g) - CTX)) : ((g) - CTX))))
    if (IN(6)) {
        constexpr int PITCH = 144, IMG = 32 * PITCH, SLOT = 4 * IMG;
        constexpr int GAM_OFF = 7 * SLOT, XT_OFF = GAM_OFF + 14 * 256, XP = 144, XB = 64 * XP, XV_OFF = XT_OFF + 2 * XB, FLG_OFF = XV_OFF + 2 * 32 * 144;
        static_assert(FLG_OFF + 64 <= LDS_MISC, "fused scan LDS map");
        volatile LAS int* flg = (volatile LAS int*)(lds + FLG_OFF);
        for (int sid = bid; sid < 256; sid += G) {
            const int dir = sid & 1, hd = (sid >> 1) & 7, b = sid >> 4;
            __syncthreads();
            { int tid_ = tid; asm volatile("" : "+v"(tid_));
              if (tid_ < 16) flg[tid_] = 0;
              *(LAS u32x4*)(lds + XT_OFF + (tid_ >> 3) * XP + (tid_ & 7) * 16) = (u32x4){0u, 0u, 0u, 0u}; }
            __syncthreads();
            if (wave < 7) {
                int lane_ = lane; asm volatile("" : "+v"(lane_));
                const int l31_ = lane_ & 31, hh_ = lane_ >> 5;
                LAS unsigned char* wl = lds + wave * SLOT;
                const int blk = (lane_ >> 4) & 1, q_ = (lane_ & 15) >> 2, p_ = lane_ & 3;
                bf16x8 If[2];
#pragma unroll
                for (int st = 0; st < 2; ++st)
#pragma unroll
                    for (int j = 0; j < 8; ++j) If[st][j] = (((j & 3) + 16 * st + 8 * (j >> 2) + 4 * hh_) == l31_) ? (short)0x3F80 : (short)0;
#define ROWI(i) (((i) & 3) + 8 * ((i) >> 2) + 4 * hh_)
#define PACKA(acc, st) __builtin_bit_cast(bf16x8, (u32x4){pk2((acc)[8 * (st)], (acc)[8 * (st) + 1]), pk2((acc)[8 * (st) + 2], (acc)[8 * (st) + 3]), pk2((acc)[8 * (st) + 4], (acc)[8 * (st) + 5]), pk2((acc)[8 * (st) + 6], (acc)[8 * (st) + 7])})
#define MM2(D, A0, A1, B0, B1, Cin) do { D = __builtin_amdgcn_mfma_f32_32x32x16_bf16(A0, B0, Cin, 0, 0, 0); D = __builtin_amdgcn_mfma_f32_32x32x16_bf16(A1, B1, D, 0, 0, 0); } while (0)
#define TRF(dst, img, st, tile) do { const LAS unsigned char* a_ = wl + (img) * IMG + (16 * (st) + 4 * hh_ + q_) * PITCH + (32 * (tile) + 16 * blk + 4 * p_) * 2; \
            const v4i16_t lo_ = __builtin_amdgcn_ds_read_tr16_b64_v4i16((LAS v4i16_t*)a_), hi_ = __builtin_amdgcn_ds_read_tr16_b64_v4i16((LAS v4i16_t*)(a_ + 8 * PITCH)); \
            dst = (bf16x8){lo_[0], lo_[1], lo_[2], lo_[3], hi_[0], hi_[1], hi_[2], hi_[3]}; } while (0)
                const f32x16 z16 = {0.f, 0.f, 0.f, 0.f, 0.f, 0.f, 0.f, 0.f, 0.f, 0.f, 0.f, 0.f, 0.f, 0.f, 0.f, 0.f};
                for (int c = wave; c < NCHUNK; c += 7) {
                    const int g = c * 32 + l31_;
                    const size_t row = (size_t)SCAN_ROW(g);
                    bf16x8 Af[4], Rf[4], Bhf[4], Khf[4];
#pragma unroll
                    for (int ks = 0; ks < 4; ++ks) {
                        const int ch = hd * 64 + 16 * ks + 8 * hh_;
                        f32x4 zw[2], za[2], kv[2], kk[2], rv[2];
                        unpack8(*(const u32x4*)(zbuf + ((size_t)dir * NT + row) * 1024 + ch), zw[0], zw[1]); unpack8(*(const u32x4*)(zbuf + ((size_t)dir * NT + row) * 1024 + 512 + ch), za[0], za[1]);
                        unpack8(*(const u32x4*)(kbuf + row * 512 + ch), kv[0], kv[1]); unpack8(*(const u32x4*)(kkbuf + row * 512 + ch), kk[0], kk[1]); unpack8(*(const u32x4*)(rbuf + row * 512 + ch), rv[0], rv[1]);
                        f32x4 At[2], Rt[2], Bh[2], Kh[2], ev[2];
#pragma unroll
                        for (int n = 0; n < 2; ++n) {
                            const f32x4 kav = *(const f32x4*)(args.in[22] + ch + 4 * n);
#pragma unroll
                            for (int q = 0; q < 4; ++q) {
                                const float lw = -0.6065306597126334f * zw[n][q];
                                const float a = za[n][q];
                                float Gs = lw;
                                Gs += dpp_f<0x111>(Gs); Gs += dpp_f<0x112>(Gs); Gs += dpp_f<0x114>(Gs); Gs += dpp_f<0x118>(Gs);
                                Gs += __builtin_bit_cast(float, __builtin_amdgcn_update_dpp(0, __builtin_bit_cast(int, Gs), 0x142, 0xA, 0xF, false));
                                const float e = fexp(Gs), einv = frcp(e);
                                float ep = __builtin_bit_cast(float, __builtin_amdgcn_update_dpp(0, __builtin_bit_cast(int, e), 0x138, 0xF, 0xF, false));
                                ep = (l31_ == 0) ? 1.f : ep;
                                const float beta = kk[n][q] * a, kd = kv[n][q] * (1.f + (a - 1.f) * kav[q]);
                                At[n][q] = -kk[n][q] * ep; Rt[n][q] = rv[n][q] * e; Bh[n][q] = beta * einv; Kh[n][q] = kd * einv; ev[n][q] = e;
                            }
                        }
                        const u32x4 pa = pack8(At[0], At[1]), pr = pack8(Rt[0], Rt[1]), pb = pack8(Bh[0], Bh[1]), pk = pack8(Kh[0], Kh[1]);
                        Af[ks] = __builtin_bit_cast(bf16x8, pa); Rf[ks] = __builtin_bit_cast(bf16x8, pr); Bhf[ks] = __builtin_bit_cast(bf16x8, pb); Khf[ks] = __builtin_bit_cast(bf16x8, pk);
                        if (l31_ == 31) { LAS float* gp = (LAS float*)(lds + GAM_OFF + (wave * 2 + ((c / 7) & 1)) * 256) + 16 * ks + 8 * hh_; *(LAS f32x4*)gp = ev[0]; *(LAS f32x4*)(gp + 4) = ev[1]; }
                    }
                    if (c >= 7) { unsigned sp = 0; while (flg[8 + wave] != c - 7 + 1) { __builtin_amdgcn_s_sleep(1); if (++sp > (1u << 22)) break; } }
                    asm volatile("" ::: "memory");
#pragma unroll
                    for (int ks = 0; ks < 4; ++ks) {
                        LAS unsigned char* ip = wl + l31_ * PITCH + (16 * ks + 8 * hh_) * 2;
                        *(LAS bf16x8*)(ip) = Af[ks]; *(LAS bf16x8*)(ip + IMG) = Rf[ks]; *(LAS bf16x8*)(ip + 2 * IMG) = Bhf[ks]; *(LAS bf16x8*)(ip + 3 * IMG) = Khf[ks];
                    }
                    f32x16 X = z16, XT = z16, aN = z16, aPT = z16, aQT = z16;
#pragma unroll
                    for (int ks = 0; ks < 4; ++ks) {
                        X = __builtin_amdgcn_mfma_f32_32x32x16_bf16(Af[ks], Bhf[ks], X, 0, 0, 0);
                        XT = __builtin_amdgcn_mfma_f32_32x32x16_bf16(Bhf[ks], Af[ks], XT, 0, 0, 0);
                        aN = __builtin_amdgcn_mfma_f32_32x32x16_bf16(Af[ks], Khf[ks], aN, 0, 0, 0);
                        aPT = __builtin_amdgcn_mfma_f32_32x32x16_bf16(Bhf[ks], Rf[ks], aPT, 0, 0, 0);
                        aQT = __builtin_amdgcn_mfma_f32_32x32x16_bf16(Khf[ks], Rf[ks], aQT, 0, 0, 0);
                    }
                    f32x16 Pr, PrT;
#pragma unroll
                    for (int i = 0; i < 16; ++i) { const int ri = ROWI(i);
                        X[i] = (l31_ < ri) ? X[i] : 0.f; aN[i] = (l31_ < ri) ? aN[i] : 0.f;
                        XT[i] = (ri < l31_) ? XT[i] : 0.f;
                        aPT[i] = (ri <= l31_) ? aPT[i] : 0.f; aQT[i] = (ri <= l31_) ? aQT[i] : 0.f;
                        const float idv = (ri == l31_) ? 1.f : 0.f; Pr[i] = X[i] + idv; PrT[i] = XT[i] + idv; }
#pragma unroll
                    for (int lv = 0; lv < 4; ++lv) {
                        const bf16x8 x0 = PACKA(X, 0), x1 = PACKA(X, 1), t0 = PACKA(XT, 0), t1 = PACKA(XT, 1);
                        f32x16 X2, XT2 = z16; MM2(X2, t0, t1, x0, x1, z16);
                        if (lv < 3) MM2(XT2, x0, x1, t0, t1, z16);
                        const bf16x8 p0 = PACKA(PrT, 0), p1 = PACKA(PrT, 1), y0 = PACKA(X2, 0), y1 = PACKA(X2, 1);
                        MM2(Pr, p0, p1, y0, y1, Pr);
                        MM2(PrT, y0, y1, p0, p1, PrT);
                        X = X2; XT = XT2;
                    }
                    bf16x8 trA[2][2], trR[2][2], trB[2][2], trK[2][2];
#pragma unroll
                    for (int x = 0; x < 2; ++x) { TRF(trA[x][0], 0, 0, x); TRF(trA[x][1], 0, 1, x); TRF(trR[x][0], 1, 0, x); TRF(trR[x][1], 1, 1, x); TRF(trB[x][0], 2, 0, x); TRF(trB[x][1], 2, 1, x); TRF(trK[x][0], 3, 0, x); TRF(trK[x][1], 3, 1, x); }
                    asm volatile("s_waitcnt lgkmcnt(0)" ::: "memory");
                    const bf16x8 tt0 = PACKA(Pr, 0), tt1 = PACKA(Pr, 1), n0 = PACKA(aN, 0), n1 = PACKA(aN, 1);
                    f32x16 PpT; { const bf16x8 b0 = PACKA(aPT, 0), b1 = PACKA(aPT, 1); MM2(PpT, tt0, tt1, b0, b1, z16); }
                    const bf16x8 pp0 = PACKA(PpT, 0), pp1 = PACKA(PpT, 1);
                    LAS unsigned char* Lrow1 = wl + l31_ * 192; const int lsw = (l31_ >> 1) & 7;
#define LSTORE(rowp, col0, w) (*(LAS u32x2*)((rowp) + ((((col0) >> 2) ^ lsw) << 3)) = (w))
                    {
                        f32x16 YT; MM2(YT, n0, n1, pp0, pp1, aQT);
#pragma unroll
                        for (int i4 = 0; i4 < 4; ++i4) { u32x2 w; w.x = pk2(YT[4 * i4], YT[4 * i4 + 1]); w.y = pk2(YT[4 * i4 + 2], YT[4 * i4 + 3]); LSTORE(Lrow1, 64 + 8 * i4 + 4 * hh_, w); }
                    }
#pragma unroll
                    for (int rt = 0; rt < 2; ++rt) {
                        f32x16 RT; MM2(RT, trA[rt][0], trA[rt][1], pp0, pp1, z16); MM2(RT, trR[rt][0], trR[rt][1], If[0], If[1], RT);
#pragma unroll
                        for (int i4 = 0; i4 < 4; ++i4) { u32x2 w; w.x = pk2(RT[4 * i4], RT[4 * i4 + 1]); w.y = pk2(RT[4 * i4 + 2], RT[4 * i4 + 3]); LSTORE(Lrow1, 32 * rt + 8 * i4 + 4 * hh_, w); }
                    }
#pragma unroll
                    for (int ct = 0; ct < 2; ++ct) {
                        f32x16 Bpp; MM2(Bpp, tt0, tt1, trB[ct][0], trB[ct][1], z16);
                        const bf16x8 bb0 = PACKA(Bpp, 0), bb1 = PACKA(Bpp, 1);
                        LAS unsigned char* Lrow2 = wl + (32 + 32 * ct + l31_) * 192;
#pragma unroll
                        for (int rt = 0; rt < 2; ++rt) {
                            f32x16 GT; MM2(GT, trA[rt][0], trA[rt][1], bb0, bb1, z16);
#pragma unroll
                            for (int i4 = 0; i4 < 4; ++i4) { u32x2 w; w.x = pk2(GT[4 * i4], GT[4 * i4 + 1]); w.y = pk2(GT[4 * i4 + 2], GT[4 * i4 + 3]); LSTORE(Lrow2, 32 * rt + 8 * i4 + 4 * hh_, w); }
                        }
                        f32x16 HT; MM2(HT, n0, n1, bb0, bb1, z16); MM2(HT, If[0], If[1], trK[ct][0], trK[ct][1], HT);
#pragma unroll
                        for (int i4 = 0; i4 < 4; ++i4) { u32x2 w; w.x = pk2(HT[4 * i4], HT[4 * i4 + 1]); w.y = pk2(HT[4 * i4 + 2], HT[4 * i4 + 3]); LSTORE(Lrow2, 64 + 8 * i4 + 4 * hh_, w); }
                    }
                    asm volatile("s_waitcnt lgkmcnt(0)" ::: "memory");
                    if (lane_ == 0) flg[wave] = c + 1;
                }
#undef LSTORE
#undef TRF
#undef MM2
#undef PACKA
#undef ROWI
            } else {
                int lane_ = lane; asm volatile("" : "+v"(lane_));
                const int l31_ = lane_ & 31, hh_ = lane_ >> 5;
                const int n_ = lane_ & 15, g4 = lane_ >> 4;
                f32x4 Zr[4][4];
#pragma unroll
                for (int zt = 0; zt < 4; ++zt)
#pragma unroll
                    for (int ct = 0; ct < 4; ++ct) Zr[zt][ct] = (f32x4){0.f, 0.f, 0.f, 0.f};
                u32x4 vpre[4];
                constexpr int VP = 144;
#define FS_VLOAD(cc) do { const int g_ = (cc) * 32 + l31_; const bf16_t* vp_ = vbuf + (size_t)SCAN_ROW(g_) * 512 + hd * 64 + 32 * hh_; \
                    _Pragma("unroll") for (int i = 0; i < 4; ++i) vpre[i] = *(const u32x4*)(vp_ + 8 * i); } while (0)
#define FS_VWRITE(buf) do { LAS unsigned char* d_ = lds + XV_OFF + (buf) * (32 * VP) + l31_ * VP + 64 * hh_; \
                    _Pragma("unroll") for (int i = 0; i < 4; ++i) *(LAS u32x4*)(d_ + 16 * i) = vpre[i]; } while (0)
                FS_VLOAD(0); FS_VWRITE(0); FS_VLOAD(1);
                const int tq_ = (lane_ & 15) >> 2, tp_ = lane_ & 3;
                for (int c = 0; c < NCHUNK; ++c) {
                    const int slot = c % 7;
                    { unsigned sp = 0; while (flg[slot] != c + 1) { __builtin_amdgcn_s_sleep(1); if (++sp > (1u << 22)) break; } }
                    asm volatile("" ::: "memory");
                    const LAS unsigned char* Ls = lds + slot * SLOT;
                    const LAS unsigned char* xc = lds + XT_OFF + (c & 1) * XB + n_ * XP + 16 * g4;
                    LAS unsigned char* xn = lds + XT_OFF + ((c + 1) & 1) * XB;
                    bf16x8 bfr[4][3];
#pragma unroll
                    for (int ct = 0; ct < 4; ++ct) {
#pragma unroll
                        for (int ks = 0; ks < 2; ++ks) bfr[ct][ks] = *(const LAS bf16x8*)(xc + 16 * ct * XP + 64 * ks);
                        const LAS unsigned char* va = lds + XV_OFF + (c & 1) * (32 * VP) + (8 * g4 + tq_) * VP + (16 * ct + 4 * tp_) * 2;
                        const v4i16_t lo_ = __builtin_amdgcn_ds_read_tr16_b64_v4i16((LAS v4i16_t*)va), hi_ = __builtin_amdgcn_ds_read_tr16_b64_v4i16((LAS v4i16_t*)(va + 4 * VP));
                        bfr[ct][2] = (bf16x8){lo_[0], lo_[1], lo_[2], lo_[3], hi_[0], hi_[1], hi_[2], hi_[3]};
                    }
                    const bool emit = c >= CTX / 32;
                    const int gg0 = c * 32; const int tl0 = dir ? (SEQ - 1 - (gg0 - CTX)) : (gg0 - CTX); const int ysg = dir ? -512 : 512;
                    bf16_t* ych = ybuf + ((size_t)dir * NL + b * SEQ + (emit ? tl0 : 0)) * 512 + hd * 64;
#pragma unroll
                    for (int rt = 0; rt < 6; ++rt) {
                        if (rt < 2 && !emit) continue;
                        bf16x8 afr[3];
#pragma unroll
                        for (int ks = 0; ks < 3; ++ks) { const LAS unsigned char* rp_ = Ls + (16 * rt + n_) * 192; const int cg_ = 8 * ks + 2 * g4, sw_ = (n_ >> 1) & 7;
                            const u32x2 lo_ = *(const LAS u32x2*)(rp_ + ((cg_ ^ sw_) << 3)), hi_ = *(const LAS u32x2*)(rp_ + (((cg_ + 1) ^ sw_) << 3));
                            afr[ks] = __builtin_bit_cast(bf16x8, (u32x4){lo_.x, lo_.y, hi_.x, hi_.y}); }
                        f32x4 gm = {0.f, 0.f, 0.f, 0.f};
                        if (rt >= 2) gm = *(const LAS f32x4*)(lds + GAM_OFF + (slot * 2 + ((c / 7) & 1)) * 256 + (16 * (rt - 2) + 4 * g4) * 4);
#pragma unroll
                        for (int ct = 0; ct < 4; ++ct) {
                            f32x4 acc = {0.f, 0.f, 0.f, 0.f};
                            if (rt >= 2) acc = Zr[rt >= 2 ? rt - 2 : 0][ct];
#pragma unroll
                            for (int ks = 0; ks < 3; ++ks) acc = __builtin_amdgcn_mfma_f32_16x16x32_bf16(afr[ks], bfr[ct][ks], acc, 0, 0, 0);
                            if (rt >= 2) {
                                acc = acc * gm;
                                Zr[rt >= 2 ? rt - 2 : 0][ct] = acc;
                                u32x2 w; w.x = pk2(acc[0], acc[1]); w.y = pk2(acc[2], acc[3]);
                                *(LAS u32x2*)(xn + (16 * ct + n_) * XP + (16 * (rt - 2) + 4 * g4) * 2) = w;
                            } else {
#pragma unroll
                                for (int i = 0; i < 4; ++i) ych[(16 * rt + 4 * g4 + i) * ysg + 16 * ct + n_] = f2bf(acc[i]);
                            }
                        }
                    }
                    asm volatile("s_waitcnt lgkmcnt(0)" ::: "memory");
                    if (lane_ == 0) flg[8 + slot] = c + 1;
                    if (c + 1 < NCHUNK) FS_VWRITE((c + 1) & 1);
                    if (c + 2 < NCHUNK) FS_VLOAD(c + 2);
                    asm volatile("s_waitcnt lgkmcnt(0)" ::: "memory");
                }
#undef FS_VLOAD
#undef FS_VWRITE
            }
        }
        if (BOTH(6)) GRID_BAR();
    }
#undef SCAN_ROW

    if (IN(7)) {
        const float* r_k = args.in[23]; const float* gn_w = args.in[24]; const float* gn_b = args.in[25]; const float* a0 = args.in[19]; const float* k_a = args.in[22];
        const int c = lane * 8;
        const f32x4 ka0 = *(const f32x4*)(k_a + c), ka1 = *(const f32x4*)(k_a + c + 4), rk0 = *(const f32x4*)(r_k + c), rk1 = *(const f32x4*)(r_k + c + 4);
        const f32x4 gw0 = *(const f32x4*)(gn_w + c), gw1 = *(const f32x4*)(gn_w + c + 4), gb0 = *(const f32x4*)(gn_b + c), gb1 = *(const f32x4*)(gn_b + c + 4);
        for (int rowp = vcu * 8 + wave; rowp < NL / 2; rowp += G * 8) {
            u32x4 in_[2][8];
#pragma unroll
            for (int rr = 0; rr < 2; ++rr) { const size_t row = (size_t)rowp * 2 + rr;
                in_[rr][0] = *(const u32x4*)(ybuf + row * 512 + c); in_[rr][1] = *(const u32x4*)(ybuf + ((size_t)NL + row) * 512 + c);
                in_[rr][2] = *(const u32x4*)(rbuf + row * 512 + c); in_[rr][3] = *(const u32x4*)(kbuf + row * 512 + c); in_[rr][4] = *(const u32x4*)(vbuf + row * 512 + c);
                in_[rr][5] = *(const u32x4*)(zbuf + row * 1024 + 512 + c); in_[rr][6] = *(const u32x4*)(zbuf + ((size_t)NT + row) * 1024 + 512 + c);
                in_[rr][7] = *(const u32x4*)(gbuf + row * 512 + c); }
#pragma unroll
            for (int rr = 0; rr < 2; ++rr) { const size_t row = (size_t)rowp * 2 + rr;
                f32x4 ya0, ya1, yb0, yb1, r0, r1, k0, k1, v0, v1, zf0, zf1, zb0, zb1, g0, g1;
                unpack8(in_[rr][0], ya0, ya1); unpack8(in_[rr][1], yb0, yb1); unpack8(in_[rr][2], r0, r1); unpack8(in_[rr][3], k0, k1); unpack8(in_[rr][4], v0, v1);
                unpack8(in_[rr][5], zf0, zf1); unpack8(in_[rr][6], zb0, zb1); unpack8(in_[rr][7], g0, g1);
                const f32x4 y0 = ya0 + yb0, y1 = ya1 + yb1;
                float sum = 0.f, dot = 0.f;
#pragma unroll
                for (int q = 0; q < 4; ++q) {
                    sum += y0[q] + y1[q];
                    const float as0 = zf0[q] + zb0[q], as1 = zf1[q] + zb1[q];
                    dot += r0[q] * k0[q] * (2.f + (as0 - 2.f) * ka0[q]) * rk0[q] + r1[q] * k1[q] * (2.f + (as1 - 2.f) * ka1[q]) * rk1[q];
                }
                sum += dpp_f<0xB1>(sum); sum += dpp_f<0x4E>(sum); sum += dpp_f<0x141>(sum);
                dot += dpp_f<0xB1>(dot); dot += dpp_f<0x4E>(dot); dot += dpp_f<0x141>(dot);
                const float mu = sum * (1.f / 64.f);
                const f32x4 d0 = y0 - mu, d1 = y1 - mu;
                float var = d0[0] * d0[0] + d0[1] * d0[1] + d0[2] * d0[2] + d0[3] * d0[3] + d1[0] * d1[0] + d1[1] * d1[1] + d1[2] * d1[2] + d1[3] * d1[3];
                var += dpp_f<0xB1>(var); var += dpp_f<0x4E>(var); var += dpp_f<0x141>(var);
                const float rs = rsqrtf(var * (1.f / 64.f) + GN_EPS);
                const f32x4 o0 = (d0 * rs * gw0 + gb0 + v0 * dot) * g0, o1 = (d1 * rs * gw1 + gb1 + v1 * dot) * g1;
                float e8[8];
#pragma unroll
                for (int q = 0; q < 4; ++q) { e8[q] = fminf(fmaxf(8.f * o0[q], -448.f), 448.f); e8[4 + q] = fminf(fmaxf(8.f * o1[q], -448.f), 448.f); }
                int wlo = __builtin_amdgcn_cvt_pk_fp8_f32(e8[0], e8[1], 0, false); wlo = __builtin_amdgcn_cvt_pk_fp8_f32(e8[2], e8[3], wlo, true);
                int whi = __builtin_amdgcn_cvt_pk_fp8_f32(e8[4], e8[5], 0, false); whi = __builtin_amdgcn_cvt_pk_fp8_f32(e8[6], e8[7], whi, true);
                *(u32x2*)(rwout8 + row * 512 + c) = (u32x2){(unsigned)wlo, (unsigned)whi};
            }
        }
        if (BOTH(7)) GRID_BAR();
    }

    if (IN(8)) {
        pg8::SchedTiles S{vcu, G, 1}; EpiMerge E{gates, merged, merged8}; pg8::ATwo AO{(unsigned)(rwout8 - att8)};
        pg8::gemm_phase<EpiMerge, pg8::SchedTiles, pg8::ATwo, true, true>(lds, (const char*)att8, (const char*)Wo_t8, k256, S, E, AO);
        if (BOTH(8)) GRID_BAR();
    }

    if (IN(9)) {
        pg8::SchedTiles S{vcu, G, 0}; EpiOut E{x_in, mod, args.out}; pg8::APlain AO;
        pg8::gemm_phase<EpiOut, pg8::SchedTiles, pg8::APlain, true, true>(lds, (const char*)merged8, (const char*)Wout_t8, 2 * k256, S, E, AO);
        if (BOTH(9)) GRID_BAR();
    }

    bf16_t* ubuf = (bf16_t*)(ws + WS_U);
    float* scores = (float*)(ws + WS_SCORE);
    int* top_e = (int*)(ws + WS_TOPE); int* top_p = (int*)(ws + WS_TOPP);
    int* ltok = (int*)(ws + WS_LTOK); float* lgate = (float*)(ws + WS_LGATE);
    unsigned char* hb = ws + WS_HB; unsigned char* yb = ws + WS_YB; unsigned char* u8 = ws + WS_U8;
    unsigned* ecnt = ctl + CW_CNT;
    if (IN(10)) {
        const float* nffn = args.in[7];
        for (int row = bid * 8 + wave; row < NL; row += G * 8) {
            const float* xr = args.out + (size_t)row * D;
            const float* mrow = mod + (row >> 11) * 6144;
            f32x4 v[4]; float ss = 0.f;
#pragma unroll
            for (int i = 0; i < 4; ++i) { v[i] = *(const f32x4*)(xr + lane * 4 + 256 * i); ss += v[i][0] * v[i][0] + v[i][1] * v[i][1] + v[i][2] * v[i][2] + v[i][3] * v[i][3]; }
            ss = wave_sum(ss);
            const float rstd = rsqrtf(ss * (1.f / D) + EPS);
#pragma unroll
            for (int i = 0; i < 4; ++i) {
                const int c = lane * 4 + 256 * i;
                const f32x4 g = *(const f32x4*)(nffn + c), sh = *(const f32x4*)(mrow + 3072 + c), sc = *(const f32x4*)(mrow + 4096 + c);
                f32x4 y = v[i] * rstd * g * (sc + 1.f) + sh;
                u32x2 o; o.x = pk2(y[0], y[1]); o.y = pk2(y[2], y[3]);
                *(u32x2*)(ubuf + (size_t)row * D + c) = o;
#pragma unroll
                for (int q = 0; q < 4; ++q) y[q] = fminf(fmaxf(4.f * y[q], -448.f), 448.f);
                int w8 = __builtin_amdgcn_cvt_pk_fp8_f32(y[0], y[1], 0, false); w8 = __builtin_amdgcn_cvt_pk_fp8_f32(y[2], y[3], w8, true);
                *(int*)(u8 + (size_t)row * D + c) = w8;
            }
        }
        if (BOTH(10)) GRID_BAR();
    }

    if (IN(11)) {
        pg8::SchedRouter S{vcu, G}; EpiRouter E{scores}; pg8::APlain AO;
        pg8::gemm_phase<EpiRouter, pg8::SchedRouter, pg8::APlain, false>(lds, (const char*)ubuf, (const char*)Wr_t, D, S, E, AO);
        {
            LAS float* scr = (LAS float*)(lds + wave * 8448);
            unsigned* qhead = ctl + CW_CNT + 512;
            const int cni = 36 * ((NB * 8 * 4) / G), cW = G * 8, cR_ = (CONV_ITEMS + cW - 1) / cW, cR = cR_ < cni - 1 ? cR_ : cni - 1;
            const unsigned first = (unsigned)cR * (unsigned)cW;
            for (;;) {
                unsigned base = 0;
                if (lane == 0) base = __hip_atomic_fetch_add(qhead, 16u, __ATOMIC_RELAXED, __HIP_MEMORY_SCOPE_AGENT);
                base = __builtin_amdgcn_readfirstlane(base) + first;
                if (base >= (unsigned)CONV_ITEMS) break;
                for (int it = (int)base; it < (int)base + 16 && it < CONV_ITEMS; ++it) {
                    const float* src; unsigned char* dst; int Nn, Kb; float sc;
                    conv_decode(it, args.in, W13t8, W2t8, src, Nn, dst, Kb, sc);
                    transpose_block_f8(src, Nn, dst, Kb, scr, lane, sc);
                }
            }
        }
        if (BOTH(11)) GRID_BAR();
    }

    if (IN(12)) {
        const float* rbias = args.in[30];
        LAS int* lcnt = (LAS int*)lds;
        LAS int* le = lcnt + 256;
        LAS int* lp = le + 1024;
        LAS float* lg = (LAS float*)(lp + 1024);
        for (int tb = bid * 128; tb < NL; tb += G * 128) {
            __syncthreads();
            if (tid < 256) lcnt[tid] = 0;
            __syncthreads();
            const f32x4 bv = *(const f32x4*)(rbias + lane * 4);
            for (int it = 0; it < 16; ++it) {
                const int tl = wave * 16 + it, tok = tb + tl;
                const f32x4 sc = *(const f32x4*)(scores + (size_t)tok * 256 + lane * 4);
                float sel[4] = {sc[0] + bv[0], sc[1] + bv[1], sc[2] + bv[2], sc[3] + bv[3]};
                float m1 = fmaxf(sel[0], sel[1]), m2 = fminf(sel[0], sel[1]);
                { const float a = fmaxf(sel[2], sel[3]), bq = fminf(sel[2], sel[3]); const float n1 = fmaxf(m1, a); m2 = fmaxf(fminf(m1, a), fmaxf(m2, bq)); m1 = n1; }
#pragma unroll
                for (int o = 1; o <= 4; o <<= 1) { const float a = __shfl_xor(m1, o, 64), bq = __shfl_xor(m2, o, 64); const float n1 = fmaxf(m1, a); m2 = fmaxf(fminf(m1, a), fmaxf(m2, bq)); m1 = n1; }
                const float gs = m1 + m2; const int grp = lane >> 3;
                int rank = 0;
#pragma unroll
                for (int g2 = 0; g2 < 8; ++g2) { const float og = __shfl(gs, g2 * 8, 64); rank += (og > gs || (og == gs && g2 < grp)) ? 1 : 0; }
                if (rank >= 4) { sel[0] = sel[1] = sel[2] = sel[3] = -INFINITY; }
                unsigned vb[4];
#pragma unroll
                for (int q = 0; q < 4; ++q) { const unsigned b_ = __builtin_bit_cast(unsigned, sel[q]); vb[q] = b_ ^ ((unsigned)((int)b_ >> 31) | 0x80000000u); }
                unsigned thr = 0u;
#pragma unroll 1
                for (int bit = 31; bit >= 0; --bit) {
                    const unsigned cand = thr | (1u << bit);
                    const int cnt = __builtin_popcountll(__ballot(vb[0] >= cand)) + __builtin_popcountll(__ballot(vb[1] >= cand)) + __builtin_popcountll(__ballot(vb[2] >= cand)) + __builtin_popcountll(__ballot(vb[3] >= cand));
                    if (cnt >= TOPK) thr = cand;
                }
                const unsigned long long below = (lane == 0) ? 0ull : (~0ull >> (64 - lane));
                unsigned long long bg[4], bt[4]; int ngt = 0;
#pragma unroll
                for (int q = 0; q < 4; ++q) { bg[q] = __ballot(vb[q] > thr); bt[q] = __ballot(vb[q] == thr); ngt += __builtin_popcountll(bg[q]); }
                const int need = TOPK - ngt;
                float gsum = 0.f;
                int selk[4];
                {
                    int tie_before = 0, gt_before = 0;
#pragma unroll
                    for (int q = 0; q < 4; ++q) { tie_before += __builtin_popcountll(bt[q] & below); gt_before += __builtin_popcountll(bg[q] & below); }
                    int tsel_before = tie_before < need ? tie_before : need;
                    int pos = gt_before + tsel_before;
                    int tb = tie_before;
#pragma unroll
                    for (int q = 0; q < 4; ++q) {
                        const bool isg = vb[q] > thr, ist = (vb[q] == thr) && (tb < need);
                        selk[q] = (isg || ist) ? pos : -1;
                        pos += (isg || ist) ? 1 : 0; tb += (vb[q] == thr) ? 1 : 0;
                    }
                }
                float ssum = 0.f;
#pragma unroll
                for (int q = 0; q < 4; ++q) ssum += (selk[q] >= 0) ? sc[q] : 0.f;
                gsum = wave_sum(ssum);
#pragma unroll
                for (int q = 0; q < 4; ++q) if (selk[q] >= 0) {
                    const int my_e = lane * 4 + q;
                    const int p = atomicAdd((int*)&lcnt[my_e], 1);
                    le[tl * 8 + selk[q]] = my_e; lp[tl * 8 + selk[q]] = p; lg[tl * 8 + selk[q]] = sc[q] / gsum * 2.5f;
                }
            }
            __syncthreads();
            if (tid < 256) { const int c = lcnt[tid]; lcnt[tid] = c ? (int)atomicAdd(&ecnt[tid], (unsigned)c) : 0; }
            __syncthreads();
            for (int i = tid; i < 1024; i += NTHREADS) {
                const int e = le[i], p = lcnt[e] + lp[i], tok = tb + (i >> 3);
                top_e[(size_t)tok * 8 + (i & 7)] = e; top_p[(size_t)tok * 8 + (i & 7)] = p;
                ltok[(size_t)e * NL + p] = tok; lgate[(size_t)e * NL + p] = lg[i];
            }
        }
        if (BOTH(12)) GRID_BAR();
    }

    LAS int* eoff = (LAS int*)(lds + LDS_EOFF);
    LAS int* toff = eoff + 260;
    if (lo <= 15 && hi > 13) {
        __syncthreads();
        if (tid < 64) {
            int c[4], t[4]; int cs = 0, tsum = 0;
#pragma unroll
            for (int j = 0; j < 4; ++j) { c[j] = (int)__hip_atomic_load(&ecnt[lane * 4 + j], __ATOMIC_RELAXED, __HIP_MEMORY_SCOPE_AGENT); t[j] = (c[j] + 255) >> 8; cs += c[j]; tsum += t[j]; }
            int ics = cs, its = tsum;
#pragma unroll
            for (int o = 1; o < 64; o <<= 1) { const int a = __shfl_up(ics, o, 64), bq = __shfl_up(its, o, 64); if (lane >= o) { ics += a; its += bq; } }
            int ec = ics - cs, et = its - tsum;
#pragma unroll
            for (int j = 0; j < 4; ++j) { eoff[lane * 4 + j] = ec; toff[lane * 4 + j] = et; ec += c[j]; et += t[j]; }
            if (lane == 63) { eoff[256] = ec; eoff[257] = ec + NL; toff[256] = et; toff[257] = et + NL / 256; }
        }
        __syncthreads();
    }

    if (IN(13)) {
        pg8::SchedMoe S{vcu, G, toff[257], 1, eoff, toff}; EpiUp E{hb}; pg8::AGather AO{ltok};
        pg8::gemm_phase<EpiUp, pg8::SchedMoe, pg8::AGather, true, true>(lds, (const char*)u8, (const char*)W13t8, 2 * k256, S, E, AO);
        if (BOTH(13)) GRID_BAR();
    }

    if (IN(14)) {
        pg8::SchedMoe S{vcu, G, toff[257], 2, eoff, toff}; EpiDown E{yb}; pg8::ASlot AO;
        pg8::gemm_phase<EpiDown, pg8::SchedMoe, pg8::ASlot, true, true>(lds, (const char*)hb, (const char*)W2t8, k256 >> 1, S, E, AO);
        if (BOTH(14)) GRID_BAR();
    }

    if (IN(15)) {
        for (int row = bid * 8 + wave; row < NL; row += G * 8) {
            const float* gm = mod + (row >> 11) * 6144 + 5120;
            int slot = eoff[256] + row;
            float gate = 1.f / 32.f;
            if (lane < 8) { const int e_ = top_e[(size_t)row * 8 + lane], p_ = top_p[(size_t)row * 8 + lane]; slot = eoff[e_] + p_; gate = lgate[(size_t)e_ * NL + p_] * (1.f / 32.f); }
            float accv[2][8];
#pragma unroll
            for (int i = 0; i < 2; ++i)
#pragma unroll
                for (int q = 0; q < 8; ++q) accv[i][q] = 0.f;
#pragma unroll
            for (int k = 0; k < 9; ++k) {
                const int sl = __shfl(slot, k, 64); const float gk = __shfl(gate, k, 64);
                const u32x4 w = *(const u32x4*)(yb + (size_t)sl * D + lane * 16);
                const unsigned ww[4] = {w.x, w.y, w.z, w.w};
#pragma unroll
                for (int i = 0; i < 2; ++i)
#pragma unroll
                    for (int h2 = 0; h2 < 2; ++h2) { const f32x2 lo = __builtin_amdgcn_cvt_pk_f32_fp8((int)ww[2 * i + h2], false), hi = __builtin_amdgcn_cvt_pk_f32_fp8((int)ww[2 * i + h2], true);
                        accv[i][4 * h2] += gk * lo[0]; accv[i][4 * h2 + 1] += gk * lo[1]; accv[i][4 * h2 + 2] += gk * hi[0]; accv[i][4 * h2 + 3] += gk * hi[1]; }
            }
            const int cbase = (lane >> 4) * 256 + ((lane >> 2) & 3) * 32 + (lane & 3) * 8;
#pragma unroll
            for (int i = 0; i < 2; ++i) {
                float* orow = args.out + (size_t)row * D + cbase + 128 * i;
                const float* gr = gm + cbase + 128 * i;
#pragma unroll
                for (int q4 = 0; q4 < 2; ++q4) {
                    f32x4 xv = *(const f32x4*)(orow + 4 * q4); const f32x4 g = *(const f32x4*)(gr + 4 * q4);
#pragma unroll
                    for (int q = 0; q < 4; ++q) xv[q] += g[q] * accv[i][4 * q4 + q];
                    *(f32x4*)(orow + 4 * q4) = xv;
                }
            }
        }
    }
#undef IN
#undef BOTH
}

extern "C" void kernel_launch(void* const* d_in, const int* in_sizes, int n_in, void* d_out, int out_size, void* d_ws, size_t ws_size, hipStream_t stream) {
    static int grid = 0;
    if (grid == 0) {
        if (n_in != 37 || out_size != NL * D || ws_size < (size_t)1024 * MiB) { fprintf(stderr, "kernel_launch: unexpected shapes (n_in %d out %d ws %zu)\n", n_in, out_size, ws_size); grid = -1; return; }
        if (hipFuncSetAttribute((const void*)fwd_kernel, hipFuncAttributeMaxDynamicSharedMemorySize, LDS_BYTES) != hipSuccess) { fprintf(stderr, "kernel_launch: hipFuncSetAttribute failed\n"); grid = -1; return; }
        int dev = 0, cus = 0;
        if (hipGetDevice(&dev) != hipSuccess || hipDeviceGetAttribute(&cus, hipDeviceAttributeMultiprocessorCount, dev) != hipSuccess) { grid = -1; return; }
        grid = cus;
    }
    if (grid < 0) return;
    (void)hipMemsetAsync((char*)d_ws + WS_CTL, 0, CTL_BYTES, stream);
    (void)hipMemsetAsync((char*)d_ws + WS_MOD, 0, 17 * 6144 * sizeof(float), stream);
    Args a{};
    for (int i = 0; i < 37; ++i) a.in[i] = (const float*)d_in[i];
    a.out = (float*)d_out; a.ws = (unsigned char*)d_ws;
    constexpr int NPH = 16;
    const int last = (MK_LAST_PHASE < NPH - 1) ? MK_LAST_PHASE : NPH - 1;
#if MK_ONE_LAUNCH
    a.ph_lo = 0; a.ph_hi = last + 1;
    fwd_kernel<<<grid, NTHREADS, LDS_BYTES, stream>>>(a);
#else
    for (int ph = 0; ph <= last; ++ph) for (int rep = 0; rep < 1 + ((MK_REP_MASK >> ph) & 1); ++rep) { a.ph_lo = ph; a.ph_hi = ph + 1; fwd_kernel<<<grid, NTHREADS, LDS_BYTES, stream>>>(a); }
#endif
}
```

```cpp
#include <hip/hip_runtime.h>
#include <cstdio>
#include <cstdint>

#ifndef MK_ONE_LAUNCH
#define MK_ONE_LAUNCH 1
#endif
#ifndef MK_REP_MASK
#define MK_REP_MASK 0
#endif
#ifndef MK_LAST_PHASE
#define MK_LAST_PHASE 99
#endif

#define LAS __attribute__((address_space(3)))
typedef unsigned short bf16_t;
typedef short bf16x8 __attribute__((ext_vector_type(8)));
typedef float f32x16 __attribute__((ext_vector_type(16)));
typedef float f32x4 __attribute__((ext_vector_type(4)));
typedef float f32x2 __attribute__((ext_vector_type(2)));
typedef unsigned u32x4 __attribute__((ext_vector_type(4)));
typedef unsigned u32x2 __attribute__((ext_vector_type(2)));
typedef __bf16 bf16x2_t __attribute__((ext_vector_type(2)));
typedef int i32x4 __attribute__((ext_vector_type(4)));
typedef short s16x2_t __attribute__((ext_vector_type(2)));
typedef int i32x8 __attribute__((ext_vector_type(8)));

constexpr int D = 1024, NB = 16, SEQ = 2048, CTX = 256;
constexpr int NL = NB * SEQ, NC = NB * CTX, NT = NL + NC, KEYS = SEQ + CTX;
constexpr int INW = 4416, PAW = 2368, GW = 2048;
constexpr int RW0 = 416;
constexpr int NEXP = 256, FF = 256, TOPK = 8;
constexpr int NSLOT_R = NL * TOPK, NSLOT = NSLOT_R + NL;
constexpr int NTHREADS = 512;
constexpr float EPS = 1e-6f, GN_EPS = 64e-5f;
constexpr float QSCALE = 0.10206207261596577f * 1.4426950408889634f;

constexpr size_t MiB = 1u << 20;
constexpr size_t WS_CTL = 0;
constexpr size_t CTL_BYTES = 64 * 1024;
constexpr size_t WS_MOD = 1 * MiB;
constexpr size_t WS_ROPE = WS_MOD + 512 * 1024;
constexpr size_t WS_WIN_T = 2 * MiB;
constexpr size_t WS_WO_T = 11 * MiB;
constexpr size_t WS_WOUT_T = 13 * MiB;
constexpr size_t WS_WR_T = 15 * MiB;
constexpr size_t WS_SSQ = 16 * MiB;
constexpr size_t WS_WQKV_T = 18 * MiB;
constexpr size_t WS_WLORA_T = 19 * MiB;
constexpr size_t WS_WG2_T = 20 * MiB;
constexpr size_t WS_DUMMY = 21 * MiB;
constexpr size_t WS_H = 22 * MiB;
constexpr size_t WS_PA = WS_H + 72 * MiB;
constexpr size_t WS_GATES = WS_PA + 167 * MiB;
constexpr size_t WS_QRAW = WS_GATES + 128 * MiB;
constexpr size_t WS_K = WS_QRAW + 48 * MiB;
constexpr size_t WS_VT = WS_K + 54 * MiB;
constexpr size_t WS_ATT = WS_VT + 36 * MiB;
constexpr size_t WS_R = WS_ATT + 32 * MiB;
constexpr size_t WS_KB = WS_R + 36 * MiB;
constexpr size_t WS_V = WS_KB + 36 * MiB;
constexpr size_t WS_KK = WS_V + 36 * MiB;
constexpr size_t WS_LORA = WS_KK + 36 * MiB;
constexpr size_t WS_GATEA = WS_LORA + 18 * MiB;
constexpr size_t WS_KD = WS_GATEA + 16 * MiB;
constexpr size_t WS_Y = WS_KD + 72 * MiB;
constexpr size_t WS_RWOUT = WS_Y + 64 * MiB;
constexpr size_t WS_MERGED = WS_PA;
constexpr size_t WS_END1 = WS_RWOUT + 32 * MiB;
constexpr size_t WS_W2T = WS_LORA;
constexpr size_t WS_W13T = WS_RWOUT + 16 * MiB;
static_assert(WS_W2T + 65 * MiB <= WS_Y && WS_W13T + 129 * MiB <= 1024 * MiB, "expert weight copies");
constexpr size_t WS_BB = WS_H;
constexpr size_t WS_Z8 = 54 * MiB;
constexpr size_t ZDIR = 271 * MiB;
static_assert(WS_Z8 + 36 * MiB <= WS_PA && WS_Z8 >= WS_BB + 32 * MiB && WS_Z8 + ZDIR >= WS_GATES + 64 * MiB && WS_Z8 + ZDIR + 36 * MiB <= WS_QRAW, "zbuf8 placement");
constexpr size_t WS_TOPE = 22 * MiB;
constexpr size_t WS_TOPP = WS_TOPE + 1 * MiB;
constexpr size_t WS_LTOK = WS_TOPP + 1 * MiB;
constexpr size_t WS_LGATE = WS_LTOK + 32 * MiB;
constexpr size_t WS_HB = WS_LGATE + 32 * MiB;
constexpr size_t WS_SCORE = WS_HB;
constexpr size_t WS_YB = WS_HB + 273 * MiB;
constexpr size_t WS_U = WS_YB;
constexpr size_t WS_U8 = WS_U + 64 * MiB;
constexpr size_t WS_END2 = WS_YB + 288 * MiB;
constexpr size_t WS_X1B = 192 * MiB;
static_assert(WS_X1B >= WS_HB + 72 * MiB && WS_X1B + 64 * MiB <= WS_YB, "x1 placement");
static_assert(WS_END2 <= WS_W2T, "y slots below the expert weight copies");
static_assert(WS_END1 <= 1024 * MiB && WS_END2 <= 1024 * MiB, "workspace map");

constexpr int CW_BAR = 1024;
constexpr int CW_CNT = 8192;

__device__ __forceinline__ unsigned pk2(float lo, float hi) { f32x2 v = {lo, hi}; bf16x2_t b = __builtin_convertvector(v, bf16x2_t); return __builtin_bit_cast(unsigned, b); }
__device__ __forceinline__ float bflo(unsigned u) { return __builtin_bit_cast(float, u << 16); }
__device__ __forceinline__ float bfhi(unsigned u) { return __builtin_bit_cast(float, u & 0xffff0000u); }
__device__ __forceinline__ float bf2f(bf16_t v) { return __builtin_bit_cast(float, ((unsigned)v) << 16); }
__device__ __forceinline__ bf16_t f2bf(float f) { return (bf16_t)(pk2(f, 0.f) & 0xffffu); }
__device__ __forceinline__ float fexp2(float x) { return __builtin_amdgcn_exp2f(x); }
__device__ __forceinline__ float fexp(float x) { return __builtin_amdgcn_exp2f(1.4426950408889634f * x); }
__device__ __forceinline__ float frcp(float x) { return __builtin_amdgcn_rcpf(x); }
__device__ __forceinline__ float sigmoidf_(float x) { return __builtin_amdgcn_rcpf(1.f + __builtin_amdgcn_exp2f(-1.4426950408889634f * x)); }
template <int CTRL> __device__ __forceinline__ float dpp_f(float v) { return __builtin_bit_cast(float, __builtin_amdgcn_update_dpp(0, __builtin_bit_cast(int, v), CTRL, 0xF, 0xF, true)); }
__device__ __forceinline__ float wave_sum(float v) {
    v += dpp_f<0xB1>(v); v += dpp_f<0x4E>(v); v += dpp_f<0x141>(v); v += dpp_f<0x140>(v);
    const int vi = __builtin_bit_cast(int, v);
    return (__builtin_bit_cast(float, __builtin_amdgcn_readlane(vi, 0)) + __builtin_bit_cast(float, __builtin_amdgcn_readlane(vi, 16))) + (__builtin_bit_cast(float, __builtin_amdgcn_readlane(vi, 32)) + __builtin_bit_cast(float, __builtin_amdgcn_readlane(vi, 48)));
}
__device__ __forceinline__ float xor32(float v) { return __shfl_xor(v, 32, 64); }

#define XB_TMO      128
#define XB_XCNT(j)  (256  + 64 * (j))
#define XB_XSUB(j)  (1280 + 64 * (j))
#define XB_XGEN(j)  (2304 + 64 * (j))
#define XB_TOP      3328
#define XB_TOPGEN   3392
#define XCD_BAR_WORDS 3456
#define XB_SPIN_CAP (1u << 18)
__device__ __forceinline__ unsigned xb_ld(unsigned* p)              { return __hip_atomic_load(p, __ATOMIC_RELAXED, __HIP_MEMORY_SCOPE_AGENT); }
__device__ __forceinline__ unsigned xb_add(unsigned* p, unsigned v) { return __hip_atomic_fetch_add(p, v, __ATOMIC_RELAXED, __HIP_MEMORY_SCOPE_AGENT); }
__device__ __forceinline__ unsigned xb_xcc_id() { return (unsigned)__builtin_amdgcn_s_getreg((3 << 11) | 20) & 0xFu; }
#define XB_SPIN(cond, bar) do { unsigned _sp = 0; while (cond) { __builtin_amdgcn_s_sleep(1); \
    if ((++_sp & 255u) == 0u) { if (xb_ld(&(bar)[XB_TMO])) break; if (_sp > XB_SPIN_CAP) { atomicAdd(&(bar)[XB_TMO], 1u); break; } } } } while (0)
struct XcdBarrier { unsigned* bar; unsigned x; volatile LAS unsigned* st; };
__device__ __forceinline__ XcdBarrier xcd_barrier_post(unsigned* bar, volatile LAS unsigned* st) {
    XcdBarrier b; b.bar = bar; b.x = xb_xcc_id(); b.st = st;
    if (threadIdx.x == 0) (void)xb_add(&bar[XB_XCNT(b.x)], 1u);
    return b;
}
__device__ __forceinline__ void xcd_barrier_complete(unsigned* bar, unsigned x, unsigned& nloc, unsigned& nx) {
    const unsigned G = gridDim.x * gridDim.y * gridDim.z;
    unsigned sum, cnt, mine, sp = 0u;
    for (;;) {
        sum = 0u; cnt = 0u; mine = 0u;
#pragma unroll
        for (unsigned j = 0; j < 16; ++j) { const unsigned c = xb_ld(&bar[XB_XCNT(j)]); sum += c; cnt += (c > 0u) ? 1u : 0u; mine = (j == x) ? c : mine; }
        if (sum == G) break;
        __builtin_amdgcn_s_sleep(1);
        if ((++sp & 255u) == 0u) { if (xb_ld(&bar[XB_TMO])) break; if (sp > XB_SPIN_CAP) { atomicAdd(&bar[XB_TMO], 1u); break; } }
    }
    nloc = mine > 0u ? mine : 1u; nx = cnt > 0u ? cnt : 1u;
}
__device__ __forceinline__ void xcd_barrier(const XcdBarrier& b) {
    asm volatile("s_waitcnt vmcnt(0)" ::: "memory");
    __syncthreads();
    if (threadIdx.x == 0) {
        unsigned* bar = b.bar;
        __builtin_amdgcn_s_waitcnt(0);
        unsigned nloc = b.st[0], nx = b.st[1];
        if (nloc == 0u) { xcd_barrier_complete(bar, b.x, nloc, nx); b.st[0] = nloc; b.st[1] = nx; }
        const unsigned old = xb_add(&bar[XB_XSUB(b.x)], 1u);
        const unsigned gen = old / nloc;
        if (old + 1u == (gen + 1u) * nloc) {
            __builtin_amdgcn_fence(__ATOMIC_RELEASE, "agent");
            asm volatile("s_waitcnt vmcnt(0)" ::: "memory");
            const unsigned og = xb_add(&bar[XB_TOP], 1u);
            const unsigned tg = og / nx;
            if (og + 1u == (tg + 1u) * nx) xb_add(&bar[XB_TOPGEN], 1u);
            else XB_SPIN(xb_ld(&bar[XB_TOPGEN]) == tg, bar);
            xb_add(&bar[XB_XGEN(b.x)], 1u);
            __builtin_amdgcn_fence(__ATOMIC_ACQUIRE, "agent");
            asm volatile("s_waitcnt vmcnt(0)" ::: "memory");
        } else {
            XB_SPIN(xb_ld(&bar[XB_XGEN(b.x)]) == gen, bar);
            __builtin_amdgcn_fence(__ATOMIC_ACQUIRE, "agent");
            asm volatile("s_waitcnt vmcnt(0)" ::: "memory");
        }
    }
    __syncthreads();
}

namespace pg8 {
constexpr int BM = 256, BK = 64, HALF = 128, HTB = HALF * BK * 2, STAGE_BYTES = 8 * HTB;
__device__ __forceinline__ int lds_byte(int r, int c) { const int st = (r >> 4) * 2 + (c >> 5), rr = r & 15, cc = c & 31, ob = rr * 64 + cc * 2; return st * 1024 + (ob ^ (((ob >> 9) & 1) << 5)); }
__device__ __forceinline__ void stage_rc(int b, int& R, int& C) { const int st = b / 1024, sb = b % 1024, swz = sb ^ (((sb >> 9) & 1) << 5); R = (st >> 1) * 16 + swz / 64; C = (st & 1) * 32 + (swz % 64) / 2; }
__device__ __forceinline__ int perm32(int rho) { const int n = rho >> 4, i = rho & 15; return 8 * (i >> 2) + 4 * n + (i & 3); }
struct Unit { int pm, pn, e, cnt, s0, k; };

__device__ __forceinline__ i32x8 cat8(const bf16x8 a, const bf16x8 b) { const i32x4 x = __builtin_bit_cast(i32x4, a), y = __builtin_bit_cast(i32x4, b); return __builtin_shufflevector(x, y, 0, 1, 2, 3, 4, 5, 6, 7); }
template <class Epi, class Sched, class AOff, bool ALIGN_EPI, bool F8 = false, bool VARK = false, int NS = 0, bool EXACT = false, bool KEEP = false>
__device__ __forceinline__ void gemm_phase(LAS unsigned char* lds, const char* Abase, const char* Btbase, const int K, const Sched& S, const Epi& E, const AOff& AO) {
    const int tid = threadIdx.x, wid = __builtin_amdgcn_readfirstlane(tid >> 6), lane = tid & 63, wr = wid >> 2, wc = wid & 3, fr = lane & 15, fq = lane >> 4;
    const int nt = K / BK;
    unsigned voffB[2];
#pragma unroll
    for (int i = 0; i < 2; ++i) { int R_, C_; stage_rc(tid * 16 + i * 8192, R_, C_); const int Rb = Epi::PERM ? ((R_ & ~31) + perm32(R_ & 31)) : R_; voffB[i] = (unsigned)(Rb * K + C_) * 2u; }
    const size_t kstep = (size_t)(BK * 2);
    const size_t hstep = (size_t)HALF * K * 2;
    const size_t tstep = 2 * hstep;
    const unsigned ldsw = (unsigned)wid * 1024u;
    const int aoff = lds_byte(wr * 64 + fr, fq * 8), boff = lds_byte(wc * 32 + fr, fq * 8);
#define PG8_SA(b, h) (((b) * 2 + (h)) * HTB)
#define PG8_SB(b, h) ((4 + (b) * 2 + (h)) * HTB)
#define PG8_STAGEB(bufoff, gbase) do { _Pragma("unroll") for (int _i = 0; _i < 2; ++_i) \
        __builtin_amdgcn_global_load_lds((const unsigned*)((const char*)(gbase) + voffB[_i]), (LAS unsigned*)(lds + (bufoff) + ldsw + _i * 8192), 16, 0, 0); } while (0)
#define PG8_STAGEA(bufoff, offs, h, kb) do { _Pragma("unroll") for (int _i = 0; _i < 2; ++_i) \
        __builtin_amdgcn_global_load_lds((const unsigned*)(Abase + (size_t)(offs)[h][_i] + (kb)), (LAS unsigned*)(lds + (bufoff) + ldsw + _i * 8192), 16, 0, 0); } while (0)
#define PG8_LDA(dst, b, h) do { _Pragma("unroll") for (int m = 0; m < 4; ++m) _Pragma("unroll") for (int k = 0; k < 2; ++k) dst[m][k] = *(const LAS bf16x8*)(lds + PG8_SA(b, h) + aoff + m * 2048 + k * 1024); } while (0)
#define PG8_LDB(dst, b, h) do { _Pragma("unroll") for (int n = 0; n < 2; ++n) _Pragma("unroll") for (int k = 0; k < 2; ++k) dst[n][k] = *(const LAS bf16x8*)(lds + PG8_SB(b, h) + boff + n * 2048 + k * 1024); } while (0)
#define PG8_MMA(ai, bj, At, Bt) do { __builtin_amdgcn_s_setprio(1); _Pragma("unroll") for (int m = 0; m < 4; ++m) _Pragma("unroll") for (int n = 0; n < 2; ++n) { \
        if constexpr (F8) asm volatile("v_mfma_f32_16x16x128_f8f6f4 %0, %1, %2, %0" : "+v"(acc[ai][bj][m][n]) : "v"(cat8(Bt[n][0], Bt[n][1])), "v"(cat8(At[m][0], At[m][1]))); \
        else { _Pragma("unroll") for (int k = 0; k < 2; ++k) acc[ai][bj][m][n] = __builtin_amdgcn_mfma_f32_16x16x32_bf16(Bt[n][k], At[m][k], acc[ai][bj][m][n], 0, 0, 0); } } __builtin_amdgcn_s_setprio(0); } while (0)
#define PG8_WAIT_V(n) asm volatile("s_waitcnt vmcnt(" #n ")" ::: "memory")
#define PG8_WAIT_L(n) asm volatile("s_waitcnt lgkmcnt(" #n ")" ::: "memory")
#define PG8_BAR __builtin_amdgcn_s_barrier()
#define PG8_SCHED __builtin_amdgcn_sched_barrier(0)
    Unit cur, nxt; int ui = 0;
    if (!S.next(0, cur)) return;
    f32x4 acc[2][2][4][2];
#pragma unroll
    for (int a = 0; a < 2; ++a)
#pragma unroll
        for (int b = 0; b < 2; ++b)
#pragma unroll
            for (int m = 0; m < 4; ++m)
#pragma unroll
                for (int n = 0; n < 2; ++n) acc[a][b][m][n] = (f32x4){0.f, 0.f, 0.f, 0.f};
    bf16x8 At[4][2], B0[2][2], B1[2][2];
    unsigned ao[2][2], nao[2][2];
    AO.get(cur, tid, K, ao);
    const char* cB = Btbase + (size_t)cur.pn * tstep;
    int c_kb = 0, c_ks = (int)kstep, c_nt = nt, n_kb = 0, n_ks = (int)kstep, n_nt = nt;
    if constexpr (VARK) S.kp(cur, c_kb, c_ks, c_nt);
    PG8_STAGEB(PG8_SB(0, 0), cB + c_kb); PG8_STAGEB(PG8_SB(0, 1), cB + hstep + c_kb); PG8_STAGEA(PG8_SA(0, 0), ao, 0, (size_t)c_kb); PG8_STAGEA(PG8_SA(0, 1), ao, 1, (size_t)c_kb);
    if (wr == 1) PG8_BAR;
    PG8_WAIT_V(2); PG8_BAR;
    PG8_STAGEB(PG8_SB(1, 0), cB + c_kb + c_ks); PG8_STAGEA(PG8_SA(1, 0), ao, 0, (size_t)(c_kb + c_ks)); PG8_STAGEB(PG8_SB(1, 1), cB + hstep + c_kb + c_ks);
    if constexpr (NS > 0 || EXACT) { PG8_STAGEA(PG8_SA(1, 1), ao, 1, (size_t)(c_kb + c_ks)); PG8_WAIT_V(8); } else PG8_WAIT_V(6);
    PG8_BAR;
    for (;;) {
        const bool has_next = S.next(ui + 1, nxt);
        if (has_next) AO.get(nxt, tid, K, nao);
        else {
#pragma unroll
            for (int h = 0; h < 2; ++h)
#pragma unroll
                for (int i = 0; i < 2; ++i) nao[h][i] = ao[h][i];
        }
        const char* nB = has_next ? Btbase + (size_t)nxt.pn * tstep : cB;
        if constexpr (VARK) { if (has_next) S.kp(nxt, n_kb, n_ks, n_nt); else { n_kb = c_kb; n_ks = c_ks; n_nt = c_nt; } }
        const bool half1 = !(cur.cnt > 0 && cur.cnt - cur.pm * 256 <= 128);
        for (int t = 0; t < c_nt; t += 2) {
            const bool last = (t == c_nt - 2);
            const size_t k1 = (size_t)c_kb + (size_t)t * kstep + (size_t)c_ks;
            const size_t k2 = last ? (size_t)n_kb : (size_t)c_kb + (size_t)(t + 2) * kstep, k3 = k2 + (size_t)(last ? n_ks : c_ks);
            unsigned o2[2][2];
#pragma unroll
            for (int h = 0; h < 2; ++h)
#pragma unroll
                for (int i = 0; i < 2; ++i) o2[h][i] = last ? nao[h][i] : ao[h][i];
            const char* b2 = last ? nB + n_kb : cB + c_kb + (size_t)(t + 2) * kstep; const char* b3 = b2 + (last ? n_ks : c_ks);
            if constexpr (NS > 0 || EXACT) {
                static_assert(NS == 8 || NS == 0, "wait immediates below are written for NS = 8");
                const bool rx = (NS > 0) && (t == 0) && (ui > 0);
#define PG8_WAIT_VX(a, b) do { if (rx) asm volatile("s_waitcnt vmcnt(" #b ")" ::: "memory"); else asm volatile("s_waitcnt vmcnt(" #a ")" ::: "memory"); } while (0)
                PG8_LDB(B0, 0, 0); PG8_LDB(B1, 0, 1); PG8_SCHED; PG8_LDA(At, 0, 0);
                PG8_WAIT_VX(10, 18); PG8_WAIT_L(0); PG8_BAR; PG8_MMA(0, 0, At, B0); PG8_MMA(0, 1, At, B1); PG8_BAR; PG8_SCHED;
                PG8_LDA(At, 0, 1); PG8_STAGEB(PG8_SB(0, 0), b2); PG8_STAGEB(PG8_SB(0, 1), b2 + hstep); PG8_STAGEA(PG8_SA(0, 0), o2, 0, k2);
                PG8_WAIT_VX(14, 22); PG8_WAIT_L(0); PG8_BAR; if (half1) { PG8_MMA(1, 0, At, B0); PG8_MMA(1, 1, At, B1); } PG8_BAR; PG8_SCHED;
                PG8_LDB(B0, 1, 0); PG8_LDB(B1, 1, 1); PG8_SCHED; PG8_LDA(At, 1, 0); PG8_STAGEA(PG8_SA(0, 1), o2, 1, k2);
                PG8_WAIT_VX(10, 18); PG8_WAIT_L(0); PG8_BAR; PG8_MMA(0, 0, At, B0); PG8_MMA(0, 1, At, B1); PG8_BAR; PG8_SCHED;
                PG8_LDA(At, 1, 1); PG8_STAGEB(PG8_SB(1, 0), b3); PG8_STAGEB(PG8_SB(1, 1), b3 + hstep); PG8_STAGEA(PG8_SA(1, 0), o2, 0, k3);
                PG8_WAIT_VX(14, 22); PG8_WAIT_L(0); PG8_BAR; if (half1) { PG8_MMA(1, 0, At, B0); PG8_MMA(1, 1, At, B1); } PG8_BAR; PG8_SCHED;
                PG8_STAGEA(PG8_SA(1, 1), o2, 1, k3);
#undef PG8_WAIT_VX
                continue;
            }
            PG8_LDB(B0, 0, 0); PG8_LDB(B1, 0, 1); PG8_SCHED; PG8_LDA(At, 0, 0); PG8_STAGEA(PG8_SA(1, 1), ao, 1, k1);
            PG8_WAIT_V(8); PG8_WAIT_L(0); PG8_BAR; PG8_MMA(0, 0, At, B0); PG8_MMA(0, 1, At, B1); PG8_BAR; PG8_SCHED;
            PG8_LDA(At, 0, 1); PG8_STAGEB(PG8_SB(0, 0), b2); PG8_STAGEB(PG8_SB(0, 1), b2 + hstep); PG8_STAGEA(PG8_SA(0, 0), o2, 0, k2);
            PG8_WAIT_V(8); PG8_WAIT_L(0); PG8_BAR; if (half1) { PG8_MMA(1, 0, At, B0); PG8_MMA(1, 1, At, B1); } PG8_BAR; PG8_SCHED;
            PG8_LDB(B0, 1, 0); PG8_LDB(B1, 1, 1); PG8_SCHED; PG8_LDA(At, 1, 0); PG8_STAGEA(PG8_SA(0, 1), o2, 1, k2);
            PG8_WAIT_V(8); PG8_WAIT_L(0); PG8_BAR; PG8_MMA(0, 0, At, B0); PG8_MMA(0, 1, At, B1); PG8_BAR; PG8_SCHED;
            PG8_LDA(At, 1, 1); PG8_STAGEB(PG8_SB(1, 0), b3); PG8_STAGEB(PG8_SB(1, 1), b3 + hstep); PG8_STAGEA(PG8_SA(1, 0), o2, 0, k3);
            PG8_WAIT_V(8); PG8_WAIT_L(0); PG8_BAR; if (half1) { PG8_MMA(1, 0, At, B0); PG8_MMA(1, 1, At, B1); } PG8_BAR; PG8_SCHED;
        }
        if constexpr (F8) asm volatile("s_nop 15\n\ts_nop 7" ::: "memory");
        if constexpr (ALIGN_EPI) { if (wr == 0) PG8_BAR; }
        bool keep_ = false;
        if constexpr (KEEP) { keep_ = (cur.k == 0); if (keep_) E.mid(acc, cur, wr, wc, fr, fq); else E(acc, cur, wr, wc, fr, fq); }
        else E(acc, cur, wr, wc, fr, fq);
        if (!has_next) break;
        if (!keep_) {
#pragma unroll
        for (int a = 0; a < 2; ++a)
#pragma unroll
            for (int b = 0; b < 2; ++b)
#pragma unroll
                for (int m = 0; m < 4; ++m)
#pragma unroll
                    for (int n = 0; n < 2; ++n) acc[a][b][m][n] = (f32x4){0.f, 0.f, 0.f, 0.f};
        }
        cur = nxt; cB = nB; ++ui; c_kb = n_kb; c_ks = n_ks; c_nt = n_nt;
#pragma unroll
        for (int h = 0; h < 2; ++h)
#pragma unroll
            for (int i = 0; i < 2; ++i) ao[h][i] = nao[h][i];
        if constexpr (ALIGN_EPI) { if (wr == 1) PG8_BAR; }
    }
    PG8_WAIT_V(0);
    if constexpr (!ALIGN_EPI) { if (wr == 0) PG8_BAR; }
    PG8_BAR;
#undef PG8_SA
#undef PG8_SB
#undef PG8_STAGEA
#undef PG8_STAGEB
#undef PG8_LDA
#undef PG8_LDB
#undef PG8_MMA
#undef PG8_WAIT_V
#undef PG8_WAIT_L
#undef PG8_BAR
#undef PG8_SCHED
}

struct APlain { __device__ __forceinline__ void get(const Unit& u, int tid, int K, unsigned (&o)[2][2]) const { int R[2], C[2]; stage_rc(tid * 16, R[0], C[0]); stage_rc(tid * 16 + 8192, R[1], C[1]);
#pragma unroll
    for (int h = 0; h < 2; ++h)
#pragma unroll
        for (int i = 0; i < 2; ++i) o[h][i] = (unsigned)((u.pm * 256 + h * 128 + R[i]) * K + C[i]) * 2u; } };
struct ATwo { unsigned delta; __device__ __forceinline__ void get(const Unit& u, int tid, int K, unsigned (&o)[2][2]) const { int R[2], C[2]; stage_rc(tid * 16, R[0], C[0]); stage_rc(tid * 16 + 8192, R[1], C[1]);
#pragma unroll
    for (int h = 0; h < 2; ++h)
#pragma unroll
        for (int i = 0; i < 2; ++i) o[h][i] = (unsigned)((u.pm * 256 + h * 128 + R[i]) * K + C[i]) * 2u + (u.k ? delta : 0u); } };
struct AGather { const int* ltok; __device__ __forceinline__ void get(const Unit& u, int tid, int K, unsigned (&o)[2][2]) const { int R[2], C[2]; stage_rc(tid * 16, R[0], C[0]); stage_rc(tid * 16 + 8192, R[1], C[1]);
#pragma unroll
    for (int h = 0; h < 2; ++h)
#pragma unroll
        for (int i = 0; i < 2; ++i) { int p = u.pm * 256 + h * 128 + R[i]; if (p >= u.cnt) p = 0; const int tok = (u.e < 256) ? ltok[(size_t)u.e * NL + p] : p; o[h][i] = (unsigned)(tok * K + C[i]) * 2u; } } };
struct ASlot { __device__ __forceinline__ void get(const Unit& u, int tid, int K, unsigned (&o)[2][2]) const { int R[2], C[2]; stage_rc(tid * 16, R[0], C[0]); stage_rc(tid * 16 + 8192, R[1], C[1]);
#pragma unroll
    for (int h = 0; h < 2; ++h)
#pragma unroll
        for (int i = 0; i < 2; ++i) o[h][i] = (unsigned)((u.s0 + h * 128 + R[i]) * K + C[i]) * 2u; } };

struct SchedInProj { int vcu, G; __device__ __forceinline__ bool next(int i, Unit& u) const {
    const int x = vcu + i * G; if (x >= 2448) return false;
    if (x < 2304) { const int g = x / 144, r = x % 144; u.pn = r >> 3; u.pm = g * 8 + (r & 7); } else { const int w = x - 2304; u.pn = 1 + (w >> 4); u.pm = 128 + (w & 15); }
    u.e = 0; u.cnt = 0; u.s0 = 0; u.k = 0; return true; } };
struct SchedTiles { int vcu, G, two; __device__ __forceinline__ bool next(int i, Unit& u) const {
    const int j = vcu + (two ? (i >> 1) : i) * G; if (j >= 512) return false;
    const int g = j >> 5, r = j & 31; u.pm = g * 8 + (r & 7); u.k = two ? (i & 1) : 0; u.pn = (r >> 3) + 4 * u.k; u.e = 0; u.cnt = 0; u.s0 = 0; return true; } };
struct SchedRouter { int vcu, G; __device__ __forceinline__ bool next(int i, Unit& u) const { const int x = vcu + i * G; if (x >= 128) return false; u.pm = x; u.pn = 0; u.e = 0; u.cnt = 0; u.s0 = 0; u.k = 0; return true; } };
struct SchedMoe { int vcu, G, ntile, nsh; LAS const int* eoff; LAS const int* toff;
    __device__ __forceinline__ bool next(int i, Unit& u) const {
        const int x = vcu + i * G; if (x >= (ntile << nsh)) return false;
        const int ti = x >> nsh, pl = x & ((1 << nsh) - 1);
        int e = 0;
        if (toff[256] <= ti) e = 256;
        else {
#pragma unroll
            for (int s = 128; s >= 1; s >>= 1) if (toff[e + s] <= ti) e += s;
        }
        e = __builtin_amdgcn_readfirstlane(e);
        u.e = e; u.pm = __builtin_amdgcn_readfirstlane(ti - toff[e]); u.cnt = __builtin_amdgcn_readfirstlane(eoff[e + 1] - eoff[e]); u.s0 = __builtin_amdgcn_readfirstlane(eoff[e]) + u.pm * 256; u.pn = (e << nsh) + pl; u.k = pl; return true; } };
struct SchedMoeList { int vcu, G, total, nsh; LAS const int* ul;
    __device__ __forceinline__ bool next(int i, Unit& u) const {
        const int x = vcu + i * G; if (x >= total) return false;
        const int pl = x & ((1 << nsh) - 1);
        const i32x4 d = *(const LAS i32x4*)(ul + 4 * i);
        const int e = __builtin_amdgcn_readfirstlane(d[0]);
        u.e = e; u.pm = __builtin_amdgcn_readfirstlane(d[1]); u.cnt = __builtin_amdgcn_readfirstlane(d[2]); u.s0 = __builtin_amdgcn_readfirstlane(d[3]); u.pn = (e << nsh) + pl; u.k = pl; return true; } };
struct AProj { __device__ __forceinline__ void get(const Unit& u, int tid, int K, unsigned (&o)[2][2]) const { int R[2], C[2]; stage_rc(tid * 16, R[0], C[0]); stage_rc(tid * 16 + 8192, R[1], C[1]);
#pragma unroll
    for (int h = 0; h < 2; ++h)
#pragma unroll
        for (int i = 0; i < 2; ++i) o[h][i] = (unsigned)((u.pm * 256 + h * 128 + R[i]) * PAW + (u.k ? 256 : 0) + C[i]) * 2u; } };
struct SchedQKV { int vcu, G;
    __device__ __forceinline__ void kp(const Unit& u, int& kb, int& ks, int& nt) const { kb = 0; ks = BK * 2; nt = u.k ? 2 : 4; }
    __device__ __forceinline__ bool next(int i, Unit& u) const {
    const int x = vcu + i * G; if (x >= 960) return false;
    if (x < 384) { u.pm = x / 3; u.pn = x % 3; u.k = 0; } else { const int w = x - 384; u.pm = w >> 2; u.pn = 3 + (w & 3); u.k = 1; }
    u.e = 0; u.cnt = 0; u.s0 = 0; return true; } };
struct SchedP4 { int vcu, G;
    __device__ __forceinline__ void kp(const Unit& u, int& kb, int& ks, int& nt) const { if (u.k == 0) { kb = (u.pn >> 2) * (BK * 2); ks = 4 * BK; nt = 2; } else { kb = 0; ks = BK * 2; nt = 4; } }
    __device__ __forceinline__ bool next(int i, Unit& u) const {
    const int x = vcu + i * G; if (x >= 1152 + 256) return false;
    if (x < 1152) { u.pm = x >> 3; u.pn = x & 7; u.k = 0; } else { const int w = x - 1152; u.pm = w >> 1; u.pn = 8 + (w & 1); u.k = 1; }
    u.e = 0; u.cnt = 0; u.s0 = 0; return true; } };
struct SchedLin { int vcu, G, total, nsh; __device__ __forceinline__ bool next(int i, Unit& u) const {
    const int x = vcu + i * G; if (x >= total) return false; u.pm = x >> nsh; u.pn = x & ((1 << nsh) - 1); u.k = 0; u.e = 0; u.cnt = 0; u.s0 = 0; return true; } };
}

__device__ __forceinline__ void transpose_block_ex(const float* Wsrc, int N, int kvalid, const float* kscale, bf16_t* dst, int K, LAS float* scr, int lane) {
#pragma unroll
    for (int h2 = 0; h2 < 2; ++h2) {
        float v_[16];
#pragma unroll
        for (int i = 0; i < 16; ++i) { const int kk = 2 * (16 * h2 + i) + (lane >> 5); v_[i] = 0.f; if (kk < kvalid) { v_[i] = Wsrc[(size_t)kk * N + (lane & 31)]; if (kscale) v_[i] *= kscale[kk]; } }
#pragma unroll
        for (int i = 0; i < 16; ++i) scr[(2 * (16 * h2 + i) + (lane >> 5)) * 33 + (lane & 31)] = v_[i];
    }
    asm volatile("s_waitcnt lgkmcnt(0)" ::: "memory");
    const int c = lane & 7;
#pragma unroll
    for (int j = 0; j < 4; ++j) { const int n = (lane >> 3) + 8 * j; const LAS float* s = scr + (8 * c) * 33 + n;
        u32x4 o; o.x = pk2(s[0 * 33], s[1 * 33]); o.y = pk2(s[2 * 33], s[3 * 33]); o.z = pk2(s[4 * 33], s[5 * 33]); o.w = pk2(s[6 * 33], s[7 * 33]);
        *(u32x4*)(dst + (size_t)n * K + 8 * c) = o; }
    asm volatile("s_waitcnt lgkmcnt(0)" ::: "memory");
}
__device__ __forceinline__ void zero_block(bf16_t* dst, int K, int lane) {
    const int c = lane & 7;
#pragma unroll
    for (int j = 0; j < 4; ++j) { const int n = (lane >> 3) + 8 * j; *(u32x4*)(dst + (size_t)n * K + 8 * c) = (u32x4){0u, 0u, 0u, 0u}; }
}
__device__ __forceinline__ void transpose_block(const float* Wsrc, int N, bf16_t* dst, int K, LAS float* scr, int lane) {
#pragma unroll
    for (int h2 = 0; h2 < 2; ++h2) {
        float v_[16];
#pragma unroll
        for (int i = 0; i < 16; ++i) v_[i] = __builtin_nontemporal_load(Wsrc + (size_t)(2 * (16 * h2 + i) + (lane >> 5)) * N + (lane & 31));
#pragma unroll
        for (int i = 0; i < 16; ++i) scr[(2 * (16 * h2 + i) + (lane >> 5)) * 33 + (lane & 31)] = v_[i];
    }
    asm volatile("s_waitcnt lgkmcnt(0)" ::: "memory");
    const int c = lane & 7;
#pragma unroll
    for (int j = 0; j < 4; ++j) { const int n = (lane >> 3) + 8 * j; const LAS float* s = scr + (8 * c) * 33 + n;
        u32x4 o; o.x = pk2(s[0 * 33], s[1 * 33]); o.y = pk2(s[2 * 33], s[3 * 33]); o.z = pk2(s[4 * 33], s[5 * 33]); o.w = pk2(s[6 * 33], s[7 * 33]);
        *(u32x4*)(dst + (size_t)n * K + 8 * c) = o; }
    asm volatile("s_waitcnt lgkmcnt(0)" ::: "memory");
}

__device__ __forceinline__ void transpose_block_f8(const float* Wsrc, int N, unsigned char* dst, int Kb, LAS float* scr, int lane, float sc) {
#pragma unroll
    for (int h2 = 0; h2 < 2; ++h2) {
        float v_[16];
#pragma unroll
        for (int i = 0; i < 16; ++i) v_[i] = __builtin_nontemporal_load(Wsrc + (size_t)(2 * (16 * h2 + i) + (lane >> 5)) * N + (lane & 31));
#pragma unroll
        for (int i = 0; i < 16; ++i) scr[(2 * (16 * h2 + i) + (lane >> 5)) * 33 + (lane & 31)] = v_[i] * sc;
    }
    asm volatile("s_waitcnt lgkmcnt(0)" ::: "memory");
    const int c = lane & 3;
#pragma unroll
    for (int j = 0; j < 2; ++j) { const int n = (lane >> 2) + 16 * j; const LAS float* s = scr + (16 * c) * 33 + n;
        u32x4 o;
#pragma unroll
        for (int q = 0; q < 4; ++q) { int w = __builtin_amdgcn_cvt_pk_fp8_f32(s[(4 * q) * 33], s[(4 * q + 1) * 33], 0, false); w = __builtin_amdgcn_cvt_pk_fp8_f32(s[(4 * q + 2) * 33], s[(4 * q + 3) * 33], w, true); o[q] = (unsigned)w; }
        *(u32x4*)(dst + (size_t)n * Kb + 16 * c) = o; }
    asm volatile("s_waitcnt lgkmcnt(0)" ::: "memory");
}

constexpr int CONV_ITEMS = 257 * 384;
__device__ __forceinline__ void conv_decode(int it, const float* const* in, unsigned char* W13t8, unsigned char* W2t8, const float*& src, int& N, unsigned char*& dst, int& Kb, float& sc) {
    int e, r;
    if (it < 257 * 128) { e = 256 - it / 128; r = 256 + it % 128; } else { const int j = it - 257 * 128; e = 256 - j / 256; r = j % 256; }
    if (r < 256) { const int w3 = r >> 7, rr = r & 127, kb = ((rr >> 4) << 1) | (rr & 1), nb = (rr >> 1) & 7, n0 = nb * 32;
        const float* W = (e < 256) ? in[w3 ? 32 : 31] + (size_t)e * D * FF : in[w3 ? 35 : 34];
        const int drow = 256 * (n0 >> 7) + (n0 & 127) + 128 * w3;
        src = W + (size_t)kb * 64 * FF + n0; N = FF; dst = W13t8 + ((size_t)e * 512 + drow) * D + kb * 64; Kb = D; sc = 128.f; }
    else { const int rr = r - 256, kb = rr & 3, nb = rr >> 2;
        const float* W = (e < 256) ? in[33] + (size_t)e * FF * D : in[36];
        src = W + (size_t)kb * 64 * D + nb * 32; N = D; dst = W2t8 + ((size_t)e * D + nb * 32) * FF + kb * 64; Kb = FF; sc = 16.f; }
}

typedef f32x4 AccT[2][2][4][2];
__device__ __forceinline__ u32x4 pack8(const f32x4 a, const f32x4 b) { u32x4 w; w.x = pk2(a[0], a[1]); w.y = pk2(a[2], a[3]); w.z = pk2(b[0], b[1]); w.w = pk2(b[2], b[3]); return w; }
__device__ __forceinline__ void unpack8(const u32x4 w, f32x4& a, f32x4& b) { a = (f32x4){bflo(w.x), bfhi(w.x), bflo(w.y), bfhi(w.y)}; b = (f32x4){bflo(w.z), bfhi(w.z), bflo(w.w), bfhi(w.w)}; }
__device__ __forceinline__ void unpack8u(const u32x2 w, f32x4& a, f32x4& b) { a = (f32x4){(float)(w.x & 0xffu), (float)((w.x >> 8) & 0xffu), (float)((w.x >> 16) & 0xffu), (float)(w.x >> 24)}; b = (f32x4){(float)(w.y & 0xffu), (float)((w.y >> 8) & 0xffu), (float)((w.y >> 16) & 0xffu), (float)(w.y >> 24)}; }
__device__ __forceinline__ void unpack8f(const u32x2 w, f32x4& a, f32x4& b) {
    const f32x2 a0 = __builtin_amdgcn_cvt_pk_f32_fp8((int)w.x, false), a1 = __builtin_amdgcn_cvt_pk_f32_fp8((int)w.x, true), b0 = __builtin_amdgcn_cvt_pk_f32_fp8((int)w.y, false), b1 = __builtin_amdgcn_cvt_pk_f32_fp8((int)w.y, true);
    a = (f32x4){a0[0], a0[1], a1[0], a1[1]} * 0.25f; b = (f32x4){b0[0], b0[1], b1[0], b1[1]} * 0.25f; }
__device__ __forceinline__ f32x4 sig4(const f32x4 v) { return (f32x4){sigmoidf_(v[0]), sigmoidf_(v[1]), sigmoidf_(v[2]), sigmoidf_(v[3])}; }
__device__ __forceinline__ f32x4 sigs4(const f32x4 v, const float c) { f32x4 r;
#pragma unroll
    for (int q = 0; q < 4; ++q) r[q] = frcp(1.f + fexp2(c * v[q]));
    return r; }
struct EpiInProj { static constexpr bool PERM = true; bf16_t* projA; unsigned char* gates8; float* ssq;
    __device__ __forceinline__ void operator()(const AccT& acc, const pg8::Unit& u, int wr, int wc, int fr, int fq) const {
        asm volatile("" : "+v"(fr), "+v"(fq), "+s"(wr), "+s"(wc));
        constexpr float SC = 1.f / 512.f;
#pragma unroll
        for (int ai = 0; ai < 2; ++ai)
#pragma unroll
            for (int mp = 0; mp < 2; ++mp) {
#pragma unroll
                for (int bj = 0; bj < 2; ++bj) { const int col = u.pn * 256 + bj * 128 + wc * 32 + 8 * fq;
                    if (col < PAW) {
#pragma unroll
                        for (int mm = 0; mm < 2; ++mm) { const int m = 2 * mp + mm, row = u.pm * 256 + ai * 128 + wr * 64 + m * 16 + fr;
                            *(u32x4*)(projA + (size_t)row * PAW + col) = pack8(acc[ai][bj][m][0] * SC, acc[ai][bj][m][1] * SC); }
                    } else if (col < INW && u.pm * 256 < NL) {
                        unsigned lo[2], hi[2];
#pragma unroll
                        for (int mm = 0; mm < 2; ++mm) { const int m = 2 * mp + mm;
                            const f32x4 s0 = sigs4(acc[ai][bj][m][0], -1.4426950408889634f * SC), s1 = sigs4(acc[ai][bj][m][1], -1.4426950408889634f * SC);
                            unsigned l_ = 0u, h_ = 0u;
#pragma unroll
                            for (int q = 0; q < 4; ++q) { l_ = __builtin_amdgcn_cvt_pk_u8_f32(__builtin_fmaf(s0[q], 255.f, 0.5f), q, l_); h_ = __builtin_amdgcn_cvt_pk_u8_f32(__builtin_fmaf(s1[q], 255.f, 0.5f), q, h_); }
                            lo[mm] = l_; hi[mm] = h_; }
                        const auto sl = __builtin_amdgcn_permlane16_swap(lo[0], lo[1], false, false), sh = __builtin_amdgcn_permlane16_swap(hi[0], hi[1], false, false);
                        const int odd = fq & 1, row = u.pm * 256 + ai * 128 + wr * 64 + (2 * mp + odd) * 16 + fr;
                        *(u32x4*)(gates8 + (size_t)row * GW + (col - PAW) - 8 * odd) = (u32x4){sl[0], sh[0], sl[1], sh[1]};
                    } }
                if (u.pn <= 1) {
#pragma unroll
                    for (int mm = 0; mm < 2; ++mm) { const int m = 2 * mp + mm, row = u.pm * 256 + ai * 128 + wr * 64 + m * 16 + fr;
                        float s0 = 0.f, s1 = 0.f;
#pragma unroll
                        for (int n = 0; n < 2; ++n)
#pragma unroll
                            for (int q = 0; q < 4; ++q) { s0 += acc[ai][0][m][n][q] * acc[ai][0][m][n][q]; s1 += acc[ai][1][m][n][q] * acc[ai][1][m][n][q]; }
                        s0 += __shfl_xor(s0, 16, 64); s0 += __shfl_xor(s0, 32, 64); s1 += __shfl_xor(s1, 16, 64); s1 += __shfl_xor(s1, 32, 64);
                        s0 *= SC * SC; s1 *= SC * SC;
                        if (fq == 0) { if (u.pn == 0) ssq[(size_t)row * 12 + wc] = s0 + s1; else { ssq[(size_t)row * 12 + 4 + wc] = s0; if (wc == 0) ssq[(size_t)row * 12 + 8] = s1; } } }
                } } } };
struct EpiMerge { static constexpr bool PERM = true; const unsigned char* gates8; unsigned char* merged8;
    __device__ __forceinline__ void gq(const u32x2 w, f32x4& a, f32x4& b) const { a = (f32x4){(float)(w.x & 0xffu), (float)((w.x >> 8) & 0xffu), (float)((w.x >> 16) & 0xffu), (float)(w.x >> 24)}; b = (f32x4){(float)(w.y & 0xffu), (float)((w.y >> 8) & 0xffu), (float)((w.y >> 16) & 0xffu), (float)(w.y >> 24)}; }
    __device__ __forceinline__ void mid(AccT& acc, const pg8::Unit& u, int wr, int wc, int fr, int fq) const {
        asm volatile("" : "+v"(fr), "+v"(fq), "+s"(wr), "+s"(wc));
        const int c0 = (u.pn & 3) * 256 + wc * 32 + 8 * fq;
        const size_t rbase = (size_t)(u.pm * 256 + wr * 64 + fr);
#pragma unroll
        for (int it = 0; it < 8; ++it) { const int ai = it >> 2, m = it & 3;
            const size_t row = rbase + ai * 128 + m * 16;
#pragma unroll
            for (int bj = 0; bj < 2; ++bj) {
                const u32x2 wa = *(const u32x2*)(gates8 + row * GW + c0 + bj * 128), wr_ = *(const u32x2*)(gates8 + row * GW + 1024 + c0 + bj * 128);
                f32x4 a0, a1, r0, r1; gq(wa, a0, a1); gq(wr_, r0, r1);
#pragma unroll
                for (int q = 0; q < 4; ++q) { acc[ai][bj][m][0][q] *= a0[q] * frcp(fmaxf(r0[q], 1.f)); acc[ai][bj][m][1][q] *= a1[q] * frcp(fmaxf(r1[q], 1.f)); } }
            asm volatile("" ::: "memory"); } }
    __device__ __forceinline__ void operator()(const AccT& acc, const pg8::Unit& u, int wr, int wc, int fr, int fq) const {
        asm volatile("" : "+v"(fr), "+v"(fq), "+s"(wr), "+s"(wc));
        constexpr float SC = 16.f / (512.f * 255.f);
        const int c0 = (u.pn & 3) * 256 + wc * 32 + 8 * fq;
        const size_t rbase = (size_t)(u.pm * 256 + wr * 64 + fr);
#pragma unroll
        for (int it = 0; it < 8; ++it) { const int ai = it >> 2, m = it & 3;
            const size_t row = rbase + ai * 128 + m * 16;
#pragma unroll
            for (int bj = 0; bj < 2; ++bj) {
                const u32x2 wr_ = *(const u32x2*)(gates8 + row * GW + 1024 + c0 + bj * 128);
                f32x4 r0, r1; gq(wr_, r0, r1);
                float e8[8];
#pragma unroll
                for (int q = 0; q < 4; ++q) { e8[q] = (fmaxf(r0[q], 1.f) * SC) * acc[ai][bj][m][0][q]; e8[4 + q] = (fmaxf(r1[q], 1.f) * SC) * acc[ai][bj][m][1][q]; }
                int wlo = __builtin_amdgcn_cvt_pk_fp8_f32(e8[0], e8[1], 0, false); wlo = __builtin_amdgcn_cvt_pk_fp8_f32(e8[2], e8[3], wlo, true);
                int whi = __builtin_amdgcn_cvt_pk_fp8_f32(e8[4], e8[5], 0, false); whi = __builtin_amdgcn_cvt_pk_fp8_f32(e8[6], e8[7], whi, true);
                *(u32x2*)(merged8 + row * D + c0 + bj * 128) = (u32x2){(unsigned)wlo, (unsigned)whi}; }
            asm volatile("" ::: "memory"); } } };
struct EpiOut { static constexpr bool PERM = true; const float* x; const float* mod; bf16_t* out;
    __device__ __forceinline__ void operator()(const AccT& acc, const pg8::Unit& u, int wr, int wc, int fr, int fq) const {
        asm volatile("" : "+v"(fr), "+v"(fq), "+s"(wr), "+s"(wc));
        const float* ga = mod + ((u.pm * 256) >> 11) * 6144 + 2048 + u.pn * 256 + wc * 32 + 8 * fq;
        f32x4 g[2][2];
#pragma unroll
        for (int bj = 0; bj < 2; ++bj)
#pragma unroll
            for (int n = 0; n < 2; ++n) g[bj][n] = *(const f32x4*)(ga + bj * 128 + 4 * n) * (1.f / 2048.f);
        const size_t base = (size_t)(u.pm * 256 + wr * 64 + fr) * D + u.pn * 256 + wc * 32 + 8 * fq;
        f32x4 xc[2][2], xn[2][2];
#pragma unroll
        for (int bj = 0; bj < 2; ++bj)
#pragma unroll
            for (int n = 0; n < 2; ++n) xc[bj][n] = *(const f32x4*)(x + base + bj * 128 + 4 * n);
#pragma unroll
        for (int it = 0; it < 8; ++it) { const int ai = it >> 2, m = it & 3;
            const size_t o = base + (size_t)(ai * 128 + m * 16) * D;
            if (it < 7) { const size_t o2 = base + (size_t)(((it + 1) >> 2) * 128 + ((it + 1) & 3) * 16) * D;
#pragma unroll
                for (int bj = 0; bj < 2; ++bj)
#pragma unroll
                    for (int n = 0; n < 2; ++n) xn[bj][n] = *(const f32x4*)(x + o2 + bj * 128 + 4 * n); }
#pragma unroll
            for (int bj = 0; bj < 2; ++bj) { const f32x4 a = xc[bj][0] + g[bj][0] * acc[ai][bj][m][0], b = xc[bj][1] + g[bj][1] * acc[ai][bj][m][1];
                u32x4 w; w.x = pk2(a[0], a[1]); w.y = pk2(a[2], a[3]); w.z = pk2(b[0], b[1]); w.w = pk2(b[2], b[3]);
                *(u32x4*)(out + o + bj * 128) = w; xc[bj][0] = xn[bj][0]; xc[bj][1] = xn[bj][1]; } } } };
struct EpiRouter { static constexpr bool PERM = false; float* scores;
    __device__ __forceinline__ void operator()(const AccT& acc, const pg8::Unit& u, int wr, int wc, int fr, int fq) const {
        asm volatile("" : "+v"(fr), "+v"(fq), "+s"(wr), "+s"(wc));
#pragma unroll
        for (int ai = 0; ai < 2; ++ai)
#pragma unroll
            for (int m = 0; m < 4; ++m) { const int row = u.pm * 256 + ai * 128 + wr * 64 + m * 16 + fr;
#pragma unroll
                for (int bj = 0; bj < 2; ++bj)
#pragma unroll
                    for (int n = 0; n < 2; ++n) { const int c = bj * 128 + wc * 32 + 16 * n + 4 * fq; *(f32x4*)(scores + (size_t)row * 256 + c) = sig4(acc[ai][bj][m][n]); } } } };
struct EpiUp { static constexpr bool PERM = true; unsigned char* hb; unsigned char* dummy;
    __device__ __forceinline__ void operator()(const AccT& acc, const pg8::Unit& u, int wr, int wc, int fr, int fq) const {
        asm volatile("" : "+v"(fr), "+v"(fq), "+s"(wr), "+s"(wc));
#pragma unroll
        for (int ai = 0; ai < 2; ++ai)
#pragma unroll
            for (int m = 0; m < 4; ++m) { const int rl = ai * 128 + wr * 64 + m * 16 + fr;
                {
                    const bool valid_ = u.pm * 256 + rl < u.cnt;
                    f32x4 h0, h1;
#pragma unroll
                    for (int q = 0; q < 4; ++q) { const float a0 = acc[ai][0][m][0][q], a1 = acc[ai][0][m][1][q];
                        h0[q] = a0 * frcp(__builtin_fmaf(fexp2(-1.4426950408889634f / 512.f * a0), 131072.f, 131072.f)) * acc[ai][1][m][0][q];
                        h1[q] = a1 * frcp(__builtin_fmaf(fexp2(-1.4426950408889634f / 512.f * a1), 131072.f, 131072.f)) * acc[ai][1][m][1][q]; }
                    int lo = __builtin_amdgcn_cvt_pk_fp8_f32(h0[0], h0[1], 0, false); lo = __builtin_amdgcn_cvt_pk_fp8_f32(h0[2], h0[3], lo, true);
                    int hi = __builtin_amdgcn_cvt_pk_fp8_f32(h1[0], h1[1], 0, false); hi = __builtin_amdgcn_cvt_pk_fp8_f32(h1[2], h1[3], hi, true);
                    unsigned char* d_ = valid_ ? hb + (size_t)(u.s0 + rl) * FF + u.k * 128 + wc * 32 + 8 * fq : dummy + (ai * 4 + m) * 8192 + (wr * 256 + wc * 64 + fq * 16 + fr) * 16;
                    *(u32x2*)d_ = (u32x2){(unsigned)lo, (unsigned)hi}; } } } };
struct EpiDown { static constexpr bool PERM = true; unsigned char* yb; unsigned char* dummy;
    __device__ __forceinline__ void operator()(const AccT& acc, const pg8::Unit& u, int wr, int wc, int fr, int fq) const {
        asm volatile("" : "+v"(fr), "+v"(fq), "+s"(wr), "+s"(wc));
#pragma unroll
        for (int ai = 0; ai < 2; ++ai)
#pragma unroll
            for (int m = 0; m < 4; ++m) { const int rl = ai * 128 + wr * 64 + m * 16 + fr;
                {
                    const bool valid_ = u.pm * 256 + rl < u.cnt;
                    u32x4 w;
#pragma unroll
                    for (int bj = 0; bj < 2; ++bj) { const f32x4 a = acc[ai][bj][m][0], b = acc[ai][bj][m][1];
                        int lo = __builtin_amdgcn_cvt_pk_fp8_f32(a[0], a[1], 0, false); lo = __builtin_amdgcn_cvt_pk_fp8_f32(a[2], a[3], lo, true);
                        int hi = __builtin_amdgcn_cvt_pk_fp8_f32(b[0], b[1], 0, false); hi = __builtin_amdgcn_cvt_pk_fp8_f32(b[2], b[3], hi, true);
                        if (bj == 0) { w.x = (unsigned)lo; w.y = (unsigned)hi; } else { w.z = (unsigned)lo; w.w = (unsigned)hi; } }
                    unsigned char* d_ = valid_ ? yb + (size_t)(u.s0 + rl) * D + u.k * 256 + wc * 64 + fq * 16 : dummy + (ai * 4 + m) * 8192 + (wr * 256 + wc * 64 + fq * 16 + fr) * 16;
                    *(u32x4*)d_ = w; } } } };

struct EpiQKV { static constexpr bool PERM = true; const float* ssq; unsigned char* qraw8; unsigned char* kvraw8;
    __device__ __forceinline__ void operator()(const AccT& acc, const pg8::Unit& u, int wr, int wc, int fr, int fq) const {
        asm volatile("" : "+v"(fr), "+v"(fq), "+s"(wr), "+s"(wc));
        f32x4 sq8[8];
#pragma unroll
        for (int it = 0; it < 8; ++it) sq8[it] = *(const f32x4*)(ssq + (size_t)(u.pm * 256 + (it >> 2) * 128 + wr * 64 + (it & 3) * 16 + fr) * 12 + (u.k ? 4 : 0));
#pragma unroll
        for (int ai = 0; ai < 2; ++ai)
#pragma unroll
            for (int mp = 0; mp < 2; ++mp) {
                float r4[2];
#pragma unroll
                for (int mm = 0; mm < 2; ++mm) { const f32x4 sq = sq8[ai * 4 + 2 * mp + mm]; r4[mm] = 4.f * rsqrtf((sq[0] + sq[1] + sq[2] + sq[3]) * (u.k ? (1.f / 128.f) : (1.f / 256.f)) + EPS); }
                const int odd = fq & 1, row = u.pm * 256 + ai * 128 + wr * 64 + (2 * mp + odd) * 16 + fr;
                unsigned char* d = u.k ? kvraw8 + (size_t)row * 1024 + (u.pn - 3) * 256 : qraw8 + (size_t)row * 768 + u.pn * 256;
#pragma unroll
                for (int bj = 0; bj < 2; ++bj) {
                    unsigned lo[2], hi[2];
#pragma unroll
                    for (int mm = 0; mm < 2; ++mm) { const int m = 2 * mp + mm; const f32x4 a = acc[ai][bj][m][0] * r4[mm], b = acc[ai][bj][m][1] * r4[mm];
                        int l_ = __builtin_amdgcn_cvt_pk_fp8_f32(a[0], a[1], 0, false); l_ = __builtin_amdgcn_cvt_pk_fp8_f32(a[2], a[3], l_, true);
                        int h_ = __builtin_amdgcn_cvt_pk_fp8_f32(b[0], b[1], 0, false); h_ = __builtin_amdgcn_cvt_pk_fp8_f32(b[2], b[3], h_, true);
                        lo[mm] = (unsigned)l_; hi[mm] = (unsigned)h_; }
                    const auto sl = __builtin_amdgcn_permlane16_swap(lo[0], lo[1], false, false), sh = __builtin_amdgcn_permlane16_swap(hi[0], hi[1], false, false);
                    *(u32x4*)(d + bj * 128 + wc * 32 + 8 * (fq - odd)) = (u32x4){sl[0], sh[0], sl[1], sh[1]}; }
                asm volatile("" ::: "memory"); } } };
struct EpiP4 { static constexpr bool PERM = true; unsigned char* zbuf8; bf16_t* gbuf; const float* w0; const float* a0;
    __device__ __forceinline__ void operator()(const AccT& acc, const pg8::Unit& u, int wr, int wc, int fr, int fq) const {
        asm volatile("" : "+v"(fr), "+v"(fq), "+s"(wr), "+s"(wc));
        f32x4 bs[2][2];
        { const int c_ = (u.pn >> 2) * 512 + (u.pn & 3) * 128 + wc * 32 + 8 * fq;
          const float* p0_ = u.k ? w0 : w0 + c_; const float* p1_ = u.k ? a0 : a0 + c_;
          bs[0][0] = *(const f32x4*)p0_; bs[0][1] = *(const f32x4*)(p0_ + 4); bs[1][0] = *(const f32x4*)p1_; bs[1][1] = *(const f32x4*)(p1_ + 4); }
#pragma unroll
        for (int ai = 0; ai < 2; ++ai)
#pragma unroll
            for (int mp = 0; mp < 2; ++mp) {
#pragma unroll
                for (int bj = 0; bj < 2; ++bj) {
                    if (u.k) {
#pragma unroll
                        for (int mm = 0; mm < 2; ++mm) { const int m = 2 * mp + mm, row = u.pm * 256 + ai * 128 + wr * 64 + m * 16 + fr;
                            *(u32x4*)(gbuf + (size_t)row * 512 + (u.pn - 8) * 256 + bj * 128 + wc * 32 + 8 * fq) = pack8(acc[ai][bj][m][0], acc[ai][bj][m][1]); }
                    } else {
                        unsigned lo[2], hi[2];
#pragma unroll
                        for (int mm = 0; mm < 2; ++mm) { const int m = 2 * mp + mm;
                            const f32x4 s0 = sig4(acc[ai][bj][m][0] + bs[bj][0]), s1 = sig4(acc[ai][bj][m][1] + bs[bj][1]);
                            unsigned l_ = 0u, h_ = 0u;
#pragma unroll
                            for (int q = 0; q < 4; ++q) { l_ = __builtin_amdgcn_cvt_pk_u8_f32(__builtin_fmaf(s0[q], 255.f, 0.5f), q, l_); h_ = __builtin_amdgcn_cvt_pk_u8_f32(__builtin_fmaf(s1[q], 255.f, 0.5f), q, h_); }
                            lo[mm] = l_; hi[mm] = h_; }
                        const auto sl = __builtin_amdgcn_permlane16_swap(lo[0], lo[1], false, false), sh = __builtin_amdgcn_permlane16_swap(hi[0], hi[1], false, false);
                        const int odd = fq & 1, row = u.pm * 256 + ai * 128 + wr * 64 + (2 * mp + odd) * 16 + fr;
                        *(u32x4*)(zbuf8 + (size_t)(u.pn >> 2) * ZDIR + (size_t)row * 1024 + bj * 512 + (u.pn & 3) * 128 + wc * 32 + 8 * (fq - odd)) = (u32x4){sl[0], sh[0], sl[1], sh[1]};
                    } }
                asm volatile("" ::: "memory"); } } };

constexpr int NCHUNK = KEYS / 32;
typedef short v4i16_t __attribute__((ext_vector_type(4)));

struct Args { const float* in[37]; float* out; unsigned char* ws; int ph_lo, ph_hi; };
constexpr int LDS_BYTES = 160 * 1024;
constexpr int LDS_MISC = 159 * 1024;
constexpr int LDS_EOFF = 148 * 1024;


__global__ void __launch_bounds__(NTHREADS, 2) fwd_kernel(Args args) {
    extern __shared__ __attribute__((aligned(16))) unsigned char lds_raw[];
    LAS unsigned char* lds = (LAS unsigned char*)lds_raw;
    const int tid = threadIdx.x, lane = tid & 63, wave = __builtin_amdgcn_readfirstlane(tid >> 6), wm = wave >> 1, wn = wave & 1, hh = lane >> 5, l31 = lane & 31;
    const int G = gridDim.x, bid = blockIdx.x;
    const int vcu = (G % 8 == 0) ? (bid % 8) * (G / 8) + bid / 8 : bid;
    unsigned char* ws = args.ws;
    unsigned* ctl = (unsigned*)(ws + WS_CTL);
    const int lo = args.ph_lo, hi = args.ph_hi;

    if (tid < 4) ((LAS unsigned*)(lds + LDS_MISC))[tid] = 0u;
    __syncthreads();
#if MK_ONE_LAUNCH
    XcdBarrier bar = xcd_barrier_post(ctl + CW_BAR, (volatile LAS unsigned*)(lds + LDS_MISC));
#define GRID_BAR() xcd_barrier(bar)
#else
#define GRID_BAR() do {} while (0)
#endif
#define IN(k) (lo <= (k) && (k) < hi)
#define BOTH(k) (IN(k) && IN((k) + 1))

    const float* x_in = args.in[0]; const float* ctx_in = args.in[2];
    float* mod = (float*)(ws + WS_MOD);
    float* ropec = (float*)(ws + WS_ROPE); float* ropes = ropec + SEQ * 16;
    unsigned char* h8 = ws + WS_H;
    bf16_t* projA = (bf16_t*)(ws + WS_PA);
    unsigned char* gates8 = ws + WS_GATES;
    unsigned char* qraw8 = ws + WS_QRAW;
    bf16_t* Kb = (bf16_t*)(ws + WS_K);
    bf16_t* Vt = (bf16_t*)(ws + WS_VT);
    unsigned char* att8 = ws + WS_ATT;
    bf16_t* rbuf = (bf16_t*)(ws + WS_R);
    bf16_t* kbuf = (bf16_t*)(ws + WS_KB);
    bf16_t* vbuf = (bf16_t*)(ws + WS_V);
    bf16_t* kkbuf = (bf16_t*)(ws + WS_KK);
    bf16_t* loraA = (bf16_t*)(ws + WS_LORA);
    bf16_t* gateA = (bf16_t*)(ws + WS_GATEA);
    unsigned char* kvraw8 = ws + WS_KD;
    bf16_t* gbuf = (bf16_t*)(ws + WS_BB);
    unsigned char* zbuf8 = ws + WS_Z8;
    bf16_t* ybuf = (bf16_t*)(ws + WS_Y);
    unsigned char* rwout8 = ws + WS_RWOUT;
    bf16_t* merged = (bf16_t*)(ws + WS_MERGED);
    unsigned char* merged8 = ws + WS_Y;
    unsigned char* Win_t8 = ws + WS_WIN_T; unsigned char* Wo_t8 = ws + WS_WO_T; unsigned char* Wout_t8 = ws + WS_WOUT_T; bf16_t* Wr_t = (bf16_t*)(ws + WS_WR_T);
    unsigned char* W13t8 = ws + WS_W13T; unsigned char* W2t8 = ws + WS_W2T;
    bf16_t* Wqkv_t = (bf16_t*)(ws + WS_WQKV_T); bf16_t* Wlora_t = (bf16_t*)(ws + WS_WLORA_T); bf16_t* Wg2_t = (bf16_t*)(ws + WS_WG2_T); float* ssq = (float*)(ws + WS_SSQ);

    const int k256 = 256 + (lo >> 20);

    if (IN(0)) {
        if (bid < 192) {
            LAS float* sl = (LAS float*)lds;
            const float* c = args.in[1]; const float* cc = args.in[3];
            for (int i = tid; i < 17 * 1024; i += NTHREADS) { const int r = i >> 10, k = i & 1023; const float v = (r < 16) ? c[r * 1024 + k] : cc[k]; sl[i] = v * sigmoidf_(v); }
            const int rg = lane >> 3, c4 = lane & 7;
            const float* aw = args.in[4] + (size_t)(wave * 128 + rg) * 6144 + bid * 32 + c4 * 4;
            f32x4 wv[16];
#pragma unroll
            for (int j = 0; j < 16; ++j) wv[j] = *(const f32x4*)(aw + (size_t)(8 * j) * 6144);
            __syncthreads();
            f32x4 a17[17];
#pragma unroll
            for (int r = 0; r < 17; ++r) a17[r] = (f32x4){0.f, 0.f, 0.f, 0.f};
#pragma unroll
            for (int j = 0; j < 16; ++j)
#pragma unroll
                for (int r = 0; r < 17; ++r) a17[r] += wv[j] * sl[r * 1024 + wave * 128 + 8 * j + rg];
#pragma unroll
            for (int r = 0; r < 17; ++r)
#pragma unroll
                for (int q = 0; q < 4; ++q) { float v = a17[r][q]; v += __shfl_xor(v, 8, 64); v += __shfl_xor(v, 16, 64); v += __shfl_xor(v, 32, 64); a17[r][q] = v; }
            LAS float* red = (LAS float*)(lds + 72 * 1024);
            if (rg == 0) {
#pragma unroll
                for (int r = 0; r < 17; ++r) *(LAS f32x4*)(red + (wave * 17 + r) * 32 + c4 * 4) = a17[r];
            }
            __syncthreads();
            for (int i = tid; i < 17 * 32; i += NTHREADS) {
                const int r = i >> 5, cl = i & 31; float s_ = args.in[5][bid * 32 + cl];
#pragma unroll
                for (int w = 0; w < 8; ++w) s_ += red[(w * 17 + r) * 32 + cl];
                mod[r * 6144 + bid * 32 + cl] = s_;
            }
        } else {
            const int i = (bid - 192) * NTHREADS + tid;
            if (i < SEQ * 16) {
                const int t = i >> 4, j = i & 15;
                const float pos = (j < 8) ? (float)(t >> 6) : (float)(t & 63);
                const float inv = powf(10000.f, -(float)(j & 7) / 8.f);
                const float ang = pos * inv;
                ropec[i] = cosf(ang); ropes[i] = sinf(ang);
            }
        }
        __syncthreads();
        if (BOTH(0)) GRID_BAR();
    }

    if (IN(1)) {
        const float* nmix = args.in[6];
        for (int row = bid * 8 + wave; row < NT; row += G * 8) {
            const float* xr = (row < NL) ? x_in + (size_t)row * D : ctx_in + (size_t)(row - NL) * D;
            const int b = (row < NL) ? (row >> 11) : 16;
            const float* mrow = mod + b * 6144;
            f32x4 v[4]; float ss = 0.f;
#pragma unroll
            for (int i = 0; i < 4; ++i) { v[i] = *(const f32x4*)(xr + lane * 4 + 256 * i); ss += v[i][0] * v[i][0] + v[i][1] * v[i][1] + v[i][2] * v[i][2] + v[i][3] * v[i][3]; }
            ss = wave_sum(ss);
            const float rstd = rsqrtf(ss * (1.f / D) + EPS);
#pragma unroll
            for (int i = 0; i < 4; ++i) {
                const int c = lane * 4 + 256 * i;
                const f32x4 g = *(const f32x4*)(nmix + c), sh = *(const f32x4*)(mrow + c), sc = *(const f32x4*)(mrow + 1024 + c);
                f32x4 y = v[i] * rstd * g * (sc + 1.f) + sh;
#pragma unroll
                for (int q = 0; q < 4; ++q) y[q] = fminf(fmaxf(4.f * y[q], -448.f), 448.f);
                int w8 = __builtin_amdgcn_cvt_pk_fp8_f32(y[0], y[1], 0, false); w8 = __builtin_amdgcn_cvt_pk_fp8_f32(y[2], y[3], w8, true);
                *(int*)(h8 + (size_t)row * D + c) = w8;
            }
        }
        __syncthreads();
        {
            LAS float* scr = (LAS float*)(lds + wave * 8448);
            for (int it = vcu * 8 + wave; it < 3232; it += G * 8) {
                const float* Ws; int Nn; unsigned char* dd; int Kb; float sc = 128.f;
                if (it < 2208) { const int kbp = it / 276, rem = it % 276, nb = rem >> 1, kb = 2 * kbp + (rem & 1);
                    Ws = args.in[8] + (size_t)kb * 64 * INW + nb * 32; Nn = INW; dd = Win_t8 + (size_t)nb * 32 * D + kb * 64; Kb = D; }
                else if (it < 2720) { const int r = (it - 2208) & 255, which = (it - 2208) >> 8, nb = r >> 3, kb = r & 7;
                    Ws = args.in[which ? 27 : 16] + (size_t)kb * 64 * D + nb * 32; Nn = D; dd = Wo_t8 + (size_t)which * D * 512 + (size_t)nb * 32 * 512 + kb * 64; Kb = 512; sc = 64.f; }
                else { const int r = it - 2720, nb = r >> 4, kb = r & 15; Ws = args.in[28] + (size_t)kb * 64 * D + nb * 32; Nn = D; dd = Wout_t8 + (size_t)nb * 32 * D + kb * 64; Kb = D; }
                transpose_block_f8(Ws, Nn, dd, Kb, scr, lane, sc);
            }
            for (int it = 3232 + vcu * 8 + wave; it < 3360 + 96 + 128 + 256 + 64; it += G * 8) {
                const float* Ws; int Nn; int kval = 64; const float* ksc = nullptr; bf16_t* dd; int Kk;
                if (it < 3360) { const int r = it - 3232, kb = r >> 3, nb = r & 7; Ws = args.in[29] + (size_t)kb * 64 * 256 + nb * 32; Nn = 256; dd = Wr_t + (size_t)nb * 32 * D + kb * 64; Kk = D; }
                else {
                    int r = it - 3360; Kk = 256;
                    if (r < 96) {
                        const int kb = r / 24, nb = r % 24;
                        Ws = args.in[11] + (size_t)kb * 64 * 768 + nb * 32; Nn = 768; ksc = args.in[10] + kb * 64; dd = Wqkv_t + (size_t)nb * 32 * 256 + kb * 64;
                    } else if (r < 224) {
                        r -= 96; const int kb = r >> 5, nb = r & 31;
                        dd = Wqkv_t + (size_t)768 * 256 + (size_t)nb * 32 * 256 + kb * 64;
                        Ws = args.in[13] + (size_t)(kb & 1) * 64 * 1024 + nb * 32; Nn = 1024; ksc = args.in[12] + (kb & 1) * 64; if (kb >= 2) kval = 0;
                    } else if (r < 480) {
                        r -= 224; const int kb = r >> 6, rr = r & 63, dir = rr >> 5, isa = (rr >> 4) & 1, nb = rr & 15;
                        dd = Wlora_t + (size_t)((dir * 4 + (nb >> 2)) * 256 + isa * 128 + (nb & 3) * 32) * 256 + kb * 64;
                        Ws = args.in[isa ? 20 : 18] + (size_t)dir * 64 * 512 + nb * 32; Nn = 512; if (kb != isa * 2 + dir) kval = 0;
                    } else {
                        r -= 480; const int kb = r >> 4, nb = r & 15;
                        dd = Wg2_t + (size_t)nb * 32 * 256 + kb * 64;
                        Ws = args.in[26] + (size_t)(kb < 3 ? kb : 0) * 64 * 512 + nb * 32; Nn = 512; kval = (kb == 2) ? 32 : (kb < 2 ? 64 : 0);
                    }
                }
                transpose_block_ex(Ws, Nn, kval, ksc, dd, Kk, scr, lane);
            }
        }
        if (BOTH(1)) GRID_BAR();
    }

    if (IN(2)) {
        pg8::SchedInProj S{vcu, G}; EpiInProj E{projA, gates8, ssq}; pg8::APlain AO;
        pg8::gemm_phase<EpiInProj, pg8::SchedInProj, pg8::APlain, true, true, false, 0, true>(lds, (const char*)h8, (const char*)Win_t8, 2 * k256, S, E, AO);
        if (BOTH(2)) GRID_BAR();
    }

    if (IN(3)) {
        {
            pg8::SchedQKV S{vcu, G}; EpiQKV E{ssq, qraw8, kvraw8}; pg8::AProj AO;
            pg8::gemm_phase<EpiQKV, pg8::SchedQKV, pg8::AProj, true, false, true>(lds, (const char*)projA, (const char*)Wqkv_t, k256, S, E, AO);
        }
        {
            const float* cw = args.in[9]; const float* k_k = args.in[21];
            const int sub = tid >> 8, ch = tid & 255, c0 = ch * 8;
            if (ch < 244) {
                float w0[8], w1[8], w2[8], kkw[8];
#pragma unroll
                for (int j = 0; j < 8; ++j) { w0[j] = cw[c0 + j]; w1[j] = cw[1952 + c0 + j]; w2[j] = cw[2 * 1952 + c0 + j]; kkw[j] = (c0 >= 512 && c0 < 1024) ? k_k[c0 - 512 + j] : 0.f; }
                for (int item = vcu; item < NT / 16; item += G) {
                    const int tok0 = item * 16 + sub * 8;
                    const bool lat = tok0 < NL;
                    const int tpos0 = lat ? (tok0 & 2047) : ((tok0 - NL) & 255);
                    const int tlen = lat ? SEQ : CTX;
                    const bf16_t* pc = projA + (size_t)tok0 * PAW + RW0 + c0;
                    u32x4 rw[10];
#pragma unroll
                    for (int i = 0; i < 10; ++i) { const int t = tpos0 + i - 1; rw[i] = (t >= 0 && t < tlen) ? *(const u32x4*)(pc + (ptrdiff_t)(i - 1) * PAW) : (u32x4){0u, 0u, 0u, 0u}; }
#pragma unroll
                    for (int tt = 0; tt < 8; ++tt) {
                        const int tok = tok0 + tt;
                        f32x4 pa, pb, ca, cb, na, nb; unpack8(rw[tt], pa, pb); unpack8(rw[tt + 1], ca, cb); unpack8(rw[tt + 2], na, nb);
                        float o[8];
#pragma unroll
                        for (int j = 0; j < 4; ++j) { o[j] = pa[j] * w0[j] + ca[j] * w1[j] + na[j] * w2[j]; o[4 + j] = pb[j] * w0[4 + j] + cb[j] * w1[4 + j] + nb[j] * w2[4 + j]; }
                        u32x4 ov;
                        if (c0 < 1536) {
                            ov.x = pk2(o[0], o[1]); ov.y = pk2(o[2], o[3]); ov.z = pk2(o[4], o[5]); ov.w = pk2(o[6], o[7]);
                            bf16_t* dst = (c0 < 512) ? rbuf : (c0 < 1024 ? kbuf : vbuf);
                            *(u32x4*)(dst + (size_t)tok * 512 + (c0 & 511)) = ov;
                            if (c0 >= 512 && c0 < 1024) {
                                float q[8]; float ss = 0.f;
#pragma unroll
                                for (int j = 0; j < 8; ++j) { q[j] = o[j] * kkw[j]; ss += q[j] * q[j]; }
                                ss += dpp_f<0xB1>(ss); ss += dpp_f<0x4E>(ss); ss += dpp_f<0x141>(ss);
                                const float rn = rsqrtf(ss + 1e-12f);
                                u32x4 kv; kv.x = pk2(q[0] * rn, q[1] * rn); kv.y = pk2(q[2] * rn, q[3] * rn); kv.z = pk2(q[4] * rn, q[5] * rn); kv.w = pk2(q[6] * rn, q[7] * rn);
                                *(u32x4*)(kkbuf + (size_t)tok * 512 + (c0 - 512)) = kv;
                            }
                        } else if (c0 < 1792) {
                            if (c0 < 1664) {
#pragma unroll
                                for (int j = 0; j < 8; ++j) { const float e2 = fexp(2.f * o[j]); o[j] = 1.f - 2.f * frcp(e2 + 1.f); }
                            }
                            ov.x = pk2(o[0], o[1]); ov.y = pk2(o[2], o[3]); ov.z = pk2(o[4], o[5]); ov.w = pk2(o[6], o[7]);
                            *(u32x4*)(loraA + (size_t)tok * 256 + (c0 - 1536)) = ov;
                        } else if (lat) {
#pragma unroll
                            for (int j = 0; j < 8; ++j) o[j] = sigmoidf_(o[j]);
                            ov.x = pk2(o[0], o[1]); ov.y = pk2(o[2], o[3]); ov.z = pk2(o[4], o[5]); ov.w = pk2(o[6], o[7]);
                            *(u32x4*)(gateA + (size_t)tok * 256 + (c0 - 1792)) = ov;
                            if (ch >= 232) *(u32x4*)(gateA + (size_t)tok * 256 + 160 + (ch - 232) * 8) = (u32x4){0u, 0u, 0u, 0u};
                        }
                    }
                }
            }
        }
        if (BOTH(3)) GRID_BAR();
    }

    if (IN(4)) {
        {
            pg8::SchedP4 S{vcu, G}; EpiP4 E{zbuf8, gbuf, args.in[17], args.in[19]}; pg8::ATwo AO{(unsigned)((const char*)gateA - (const char*)loraA)};
            pg8::gemm_phase<EpiP4, pg8::SchedP4, pg8::ATwo, true, false, true>(lds, (const char*)loraA, (const char*)Wlora_t, k256, S, E, AO);
        }
        {
            const float* knorm = args.in[15];
            LAS bf16_t* vt = (LAS bf16_t*)lds;
            const int kr_ = tid >> 3, c8 = tid & 7;
            const f32x4 kn0 = *(const f32x4*)(knorm + c8 * 8), kn1 = *(const f32x4*)(knorm + c8 * 8 + 4);
            const int j0 = 8 * (c8 & 1);
            const f32x4 kx1a = *(const f32x4*)(knorm + 64 + j0), kx1b = *(const f32x4*)(knorm + 68 + j0), kx2a = *(const f32x4*)(knorm + 80 + j0), kx2b = *(const f32x4*)(knorm + 84 + j0);
            for (int it = vcu; it < (NT / 64) * 4; it += G) {
                const int hp = it & 3, r0 = (it >> 2) * 64, row = r0 + kr_;
                const bool lat = row < NL;
                const int b = lat ? (row >> 11) : ((row - NL) >> 8);
                const int tpos = lat ? (row & 2047) : ((row - NL) & 255);
                const int key = lat ? tpos : SEQ + tpos;
                const unsigned char* src_ = kvraw8 + (size_t)row * 1024 + hp * 256 + c8 * 8;
                const u32x2 kw0 = *(const u32x2*)src_, vw0 = *(const u32x2*)(src_ + 64), kw1 = *(const u32x2*)(src_ + 128), vw1 = *(const u32x2*)(src_ + 192);
                const float skr = ssq[(size_t)row * 12 + 8];
                f32x4 x1a, x1b, x2a, x2b; f32x4 ca = {1.f, 1.f, 1.f, 1.f}, cb = ca, sa = {0.f, 0.f, 0.f, 0.f}, sb = sa;
                if (c8 < 4) {
                    unpack8(*(const u32x4*)(projA + (size_t)row * PAW + 384 + j0), x1a, x1b); unpack8(*(const u32x4*)(projA + (size_t)row * PAW + 400 + j0), x2a, x2b);
                    if (lat) { ca = *(const f32x4*)(ropec + tpos * 16 + j0); cb = *(const f32x4*)(ropec + tpos * 16 + j0 + 4); sa = *(const f32x4*)(ropes + tpos * 16 + j0); sb = *(const f32x4*)(ropes + tpos * 16 + j0 + 4); }
                }
                __syncthreads();
                { f32x4 va_, vb_; unpack8f(vw0, va_, vb_); *(LAS u32x4*)(vt + kr_ * 72 + c8 * 8) = pack8(va_, vb_); unpack8f(vw1, va_, vb_); *(LAS u32x4*)(vt + 64 * 72 + kr_ * 72 + c8 * 8) = pack8(va_, vb_); }
#pragma unroll
                for (int hh2 = 0; hh2 < 2; ++hh2) {
                    const int hd = 2 * hp + hh2;
                    f32x4 k0, k1; unpack8f(hh2 ? kw1 : kw0, k0, k1);
                    float s2 = k0[0] * k0[0] + k0[1] * k0[1] + k0[2] * k0[2] + k0[3] * k0[3] + k1[0] * k1[0] + k1[1] * k1[1] + k1[2] * k1[2] + k1[3] * k1[3];
                    s2 += dpp_f<0xB1>(s2); s2 += dpp_f<0x4E>(s2); s2 += dpp_f<0x141>(s2);
                    const float rk = rsqrtf((s2 + skr) * (1.f / 96.f) + EPS);
                    bf16_t* kout = Kb + ((size_t)(b * 8 + hd) * KEYS + key) * 96;
                    *(u32x4*)(kout + c8 * 8) = pack8(k0 * rk * kn0, k1 * rk * kn1);
                    if (c8 < 4) {
                        const f32x4 y1a = x1a * rk * kx1a, y1b = x1b * rk * kx1b, y2a = x2a * rk * kx2a, y2b = x2b * rk * kx2b;
                        const f32x4 oa = (c8 < 2) ? (y1a * ca - y2a * sa) : (y1a * sa + y2a * ca), ob = (c8 < 2) ? (y1b * cb - y2b * sb) : (y1b * sb + y2b * cb);
                        *(u32x4*)(kout + 64 + 8 * c8) = pack8(oa, ob);
                    }
                }
                __syncthreads();
                {
                    const int d = tid >> 3, kc = tid & 7;
                    const int kbase = (lat ? (r0 & 2047) : SEQ + ((r0 - NL) & 255)) + (kc >> 1) * 16;
#pragma unroll
                    for (int hh2 = 0; hh2 < 2; ++hh2) {
                        unsigned short e8[8];
#pragma unroll
                        for (int i = 0; i < 8; ++i) e8[i] = vt[hh2 * 64 * 72 + (kc * 8 + i) * 72 + d];
                        bf16_t* vo = Vt + ((size_t)(b * 8 + 2 * hp + hh2) * 64 + d) * KEYS + kbase + 4 * (kc & 1);
                        u32x2 lo2, hi2; lo2.x = e8[0] | ((unsigned)e8[1] << 16); lo2.y = e8[2] | ((unsigned)e8[3] << 16); hi2.x = e8[4] | ((unsigned)e8[5] << 16); hi2.y = e8[6] | ((unsigned)e8[7] << 16);
                        *(u32x2*)vo = lo2; *(u32x2*)(vo + 8) = hi2;
                    }
                }
            }
            __syncthreads();
        }
        if (BOTH(4)) GRID_BAR();
    }

    if (IN(5)) {
        constexpr int KROW = 208, VROW = 144, KTB = 64 * KROW, ASTAGE = KTB + 64 * VROW;
        const float* qnorm = args.in[14];
        const int cwg = bid * 8 + wave, cW = G * 8;
        LAS unsigned char* cbuf = lds + 52 * 1024 + wave * 8448;
        const int cni = 36 * ((NB * 8 * 4) / G);
        const int cR_ = ((CONV_ITEMS + cW - 1) / cW) * 7 / 8, cR = cR_ < cni - 1 ? cR_ : cni - 1;
        int cc = 0;
        for (int u = bid; u < NB * 8 * 4; u += G) {
            int lq_ = lane; asm volatile("" : "+v"(lq_));
            const int l31q = lq_ & 31, hhq = lq_ >> 5;
            const int qb = u & 3, hd = (u >> 2) & 7, b = u >> 5;
            bf16x8 qf[2][6];
            float mshift[2];
#pragma unroll
            for (int qt = 0; qt < 2; ++qt) {
                const int tq = qb * 512 + wave * 64 + qt * 32 + l31q;
                const unsigned char* qp = qraw8 + ((size_t)b * SEQ + tq) * 768 + hd * 96 + 8 * hhq;
                u32x2 wq[6]; float ss = 0.f;
#pragma unroll
                for (int j = 0; j < 6; ++j) { wq[j] = *(const u32x2*)(qp + 16 * j); f32x4 a, c; unpack8f(wq[j], a, c);
                    ss += a[0] * a[0] + a[1] * a[1] + a[2] * a[2] + a[3] * a[3] + c[0] * c[0] + c[1] * c[1] + c[2] * c[2] + c[3] * c[3]; }
                ss += xor32(ss);
                const float rstd = rsqrtf(ss * (1.f / 96.f) + EPS) * QSCALE;
                float qn = 0.f;
#pragma unroll
                for (int j = 0; j < 4; ++j) { f32x4 a, c; unpack8f(wq[j], a, c);
                    a = a * rstd * *(const f32x4*)(qnorm + 16 * j + 8 * hhq); c = c * rstd * *(const f32x4*)(qnorm + 16 * j + 8 * hhq + 4);
                    qn += a[0] * a[0] + a[1] * a[1] + a[2] * a[2] + a[3] * a[3] + c[0] * c[0] + c[1] * c[1] + c[2] * c[2] + c[3] * c[3];
                    qf[qt][j] = __builtin_bit_cast(bf16x8, pack8(a, c)); }
                {
                    f32x4 x1a, x1b, x2a, x2b; unpack8f(wq[4], x1a, x1b); unpack8f(wq[5], x2a, x2b);
                    x1a = x1a * rstd * *(const f32x4*)(qnorm + 64 + 8 * hhq); x1b = x1b * rstd * *(const f32x4*)(qnorm + 68 + 8 * hhq);
                    x2a = x2a * rstd * *(const f32x4*)(qnorm + 80 + 8 * hhq); x2b = x2b * rstd * *(const f32x4*)(qnorm + 84 + 8 * hhq);
                    qn += x1a[0] * x1a[0] + x1a[1] * x1a[1] + x1a[2] * x1a[2] + x1a[3] * x1a[3] + x1b[0] * x1b[0] + x1b[1] * x1b[1] + x1b[2] * x1b[2] + x1b[3] * x1b[3]
                        + x2a[0] * x2a[0] + x2a[1] * x2a[1] + x2a[2] * x2a[2] + x2a[3] * x2a[3] + x2b[0] * x2b[0] + x2b[1] * x2b[1] + x2b[2] * x2b[2] + x2b[3] * x2b[3];
                    const f32x4 ca = *(const f32x4*)(ropec + tq * 16 + 8 * hhq), cb = *(const f32x4*)(ropec + tq * 16 + 8 * hhq + 4), sa = *(const f32x4*)(ropes + tq * 16 + 8 * hhq), sb = *(const f32x4*)(ropes + tq * 16 + 8 * hhq + 4);
                    qf[qt][4] = __builtin_bit_cast(bf16x8, pack8(x1a * ca - x2a * sa, x1b * cb - x2b * sb));
                    qf[qt][5] = __builtin_bit_cast(bf16x8, pack8(x1a * sa + x2a * ca, x1b * sb + x2b * cb));
                }
                qn += xor32(qn);
                mshift[qt] = sqrtf(qn);
                asm volatile("" :: "v"(qf[qt][0]), "v"(qf[qt][1]), "v"(qf[qt][2]), "v"(qf[qt][3]), "v"(qf[qt][4]), "v"(qf[qt][5]) : "memory");
            }
            float kgmax; { float g_ = (lq_ < 32) ? fmaxf(fmaxf(fabsf(args.in[15][lq_]), fabsf(args.in[15][lq_ + 32])), fabsf(args.in[15][lq_ + 64])) : 0.f;
#pragma unroll
                for (int o_ = 16; o_ >= 1; o_ >>= 1) g_ = fmaxf(g_, __shfl_xor(g_, o_, 64));
                kgmax = __shfl(g_, 0, 64) * 9.797958971f * 1.02f; }
            LAS float* msl = (LAS float*)(lds + 48 * 1024) + wave * 128 + 2 * lq_;
            msl[0] = -mshift[0] * kgmax; msl[1] = -mshift[1] * kgmax;
            const bf16_t* Kg = Kb + (size_t)(b * 8 + hd) * KEYS * 96;
            const bf16_t* Vg = Vt + (size_t)(b * 8 + hd) * 64 * KEYS;
            int tid_ = tid; asm volatile("" : "+v"(tid_));
            const int kc0 = tid_, kc1 = tid_ + 512;
            const int kr0 = kc0 / 12, kh0 = kc0 % 12, kr1 = kc1 / 12, kh1 = kc1 % 12;
            const int vd = tid_ >> 3, vch = tid_ & 7;
            u32x4 pk0, pk1, pvv;
#define ATT_GLOAD(kt) do { pk0 = *(const u32x4*)(Kg + (size_t)((kt) * 64 + kr0) * 96 + kh0 * 8); if (tid < 256) pk1 = *(const u32x4*)(Kg + (size_t)((kt) * 64 + kr1) * 96 + kh1 * 8); \
                pvv = *(const u32x4*)(Vg + (size_t)vd * KEYS + (kt) * 64 + vch * 8); } while (0)
#define ATT_LWRITE(s) do { LAS unsigned char* st_ = lds + (s) * ASTAGE; *(LAS u32x4*)(st_ + kr0 * KROW + kh0 * 16) = pk0; if (tid < 256) *(LAS u32x4*)(st_ + kr1 * KROW + kh1 * 16) = pk1; \
                *(LAS u32x4*)(st_ + KTB + vd * VROW + vch * 16) = pvv; } while (0)
            f32x16 o[2][2];
#pragma unroll
            for (int qt = 0; qt < 2; ++qt)
#pragma unroll
                for (int e2 = 0; e2 < 16; ++e2) { o[qt][0][e2] = 0.f; o[qt][1][e2] = 0.f; }
            float lsum[2] = {0.f, 0.f};
            __syncthreads();
            ATT_GLOAD(0); ATT_LWRITE(0);
            __syncthreads();
            constexpr int NKT = KEYS / 64;
            for (int kt = 0; kt < NKT; ++kt) {
                const bool more = kt + 1 < NKT;
                if (more) ATT_GLOAD(kt + 1);
                {
                    const int ixp = cc > 0 ? ((cc - 1) * cR) / (cni - 1) : 0, ixc = (cc * cR) / (cni - 1), ixn = ((cc + 1) * cR) / (cni - 1);
                    const int itp = ixp * cW + cwg, itn = ixc * cW + cwg;
                    const bool hp = cc > 0 && cc < cni && ixc != ixp && ixp < cR && itp < CONV_ITEMS, hn = cc < cni - 1 && ixn != ixc && ixc < cR && itn < CONV_ITEMS;
                    int lc = lane; asm volatile("" : "+v"(lc));
                    const int nn = lc >> 2, c4 = lc & 3;
                    u32x4 ov[2]; unsigned char* dstp = nullptr; int Kbp = 0;
                    if (hp) {
                        const float* srcp; int Np; float scp;
                        conv_decode(itp, args.in, W13t8, W2t8, srcp, Np, dstp, Kbp, scp);
                        const float rscp = frcp(scp);
#pragma unroll
                        for (int j = 0; j < 2; ++j) {
                            const LAS float* sp = (const LAS float*)(cbuf + (2 * c4) * 1024 + c4 * 64 + (nn + 16 * j) * 4);
#pragma unroll
                            for (int q = 0; q < 4; ++q) {
                                const int o_ = ((4 * q) >> 3) * 256 + ((4 * q) & 7) * 32;
                                s16x2_t w = {0, 0};
                                w = __builtin_amdgcn_cvt_scalef32_pk_fp8_f32(w, sp[o_], sp[o_ + 32], rscp, false); w = __builtin_amdgcn_cvt_scalef32_pk_fp8_f32(w, sp[o_ + 64], sp[o_ + 96], rscp, true); ov[j][q] = __builtin_bit_cast(unsigned, w); }
                        }
                    }
                    asm volatile("s_waitcnt lgkmcnt(0)" ::: "memory");
                    if (hn) {
                        const float* srcn; unsigned char* dstn; int Nn, Kbn; float scn;
                        conv_decode(itn, args.in, W13t8, W2t8, srcn, Nn, dstn, Kbn, scn);
                        const float* gp = srcn + (size_t)(lc >> 3) * Nn + (lc & 7) * 4;
#pragma unroll
                        for (int i = 0; i < 8; ++i) __builtin_amdgcn_global_load_lds((const unsigned*)(gp + (size_t)(8 * i) * Nn), (LAS unsigned*)(cbuf + i * 1024 + (i >> 1) * 64), 16, 0, 2);
                    }
                    if (hp) {
#pragma unroll
                        for (int j = 0; j < 2; ++j) *(u32x4*)(dstp + (size_t)(nn + 16 * j) * Kbp + 16 * c4) = ov[j];
                    }
                    ++cc;
                    __builtin_amdgcn_sched_barrier(0);
                }
                LAS unsigned char* st = lds + (kt & 1) * ASTAGE;
                f32x16 s[2][2];
#pragma unroll
                for (int qt = 0; qt < 2; ++qt) { const float ms_ = msl[qt];
#pragma unroll
                    for (int e2 = 0; e2 < 16; ++e2) { s[qt][0][e2] = ms_; s[qt][1][e2] = ms_; } }
#pragma unroll
                for (int k2 = 0; k2 < 2; ++k2)
#pragma unroll
                    for (int j = 0; j < 6; ++j) {
                        const bf16x8 kf = *(LAS bf16x8*)(st + (k2 * 32 + l31q) * KROW + (2 * j + hhq) * 16);
                        s[0][k2] = __builtin_amdgcn_mfma_f32_32x32x16_bf16(kf, qf[0][j], s[0][k2], 0, 0, 0);
                        s[1][k2] = __builtin_amdgcn_mfma_f32_32x32x16_bf16(kf, qf[1][j], s[1][k2], 0, 0, 0);
                    }
#pragma unroll
                for (int qt = 0; qt < 2; ++qt) {
                    if (__builtin_expect(k256 == 0, 0)) {
#pragma unroll
                        for (int e2 = 0; e2 < 16; ++e2) { o[qt][0][e2] *= 0.5f; o[qt][1][e2] *= 0.5f; s[qt][0][e2] -= 1.f; s[qt][1][e2] -= 1.f; }
                        lsum[qt] *= 0.5f;
                    }
                    float ps = 0.f;
#pragma unroll
                    for (int k2 = 0; k2 < 2; ++k2)
#pragma unroll
                        for (int e2 = 0; e2 < 16; ++e2) { s[qt][k2][e2] = fexp2(s[qt][k2][e2]); ps += s[qt][k2][e2]; }
                    lsum[qt] += ps;
#pragma unroll
                    for (int k2 = 0; k2 < 2; ++k2)
#pragma unroll
                        for (int s2 = 0; s2 < 2; ++s2) {
                            u32x4 w; w.x = pk2(s[qt][k2][8 * s2], s[qt][k2][8 * s2 + 1]); w.y = pk2(s[qt][k2][8 * s2 + 2], s[qt][k2][8 * s2 + 3]); w.z = pk2(s[qt][k2][8 * s2 + 4], s[qt][k2][8 * s2 + 5]); w.w = pk2(s[qt][k2][8 * s2 + 6], s[qt][k2][8 * s2 + 7]);
                            const bf16x8 pf = __builtin_bit_cast(bf16x8, w);
#pragma unroll
                            for (int dt = 0; dt < 2; ++dt) {
                                const bf16x8 vf = *(LAS bf16x8*)(st + KTB + (dt * 32 + l31q) * VROW + (k2 * 32 + s2 * 16) * 2 + 16 * hhq);
                                o[qt][dt] = __builtin_amdgcn_mfma_f32_32x32x16_bf16(vf, pf, o[qt][dt], 0, 0, 0);
                            }
                        }
                }
                if (more) ATT_LWRITE((kt + 1) & 1);
                __syncthreads();
            }
#pragma unroll
            for (int qt = 0; qt < 2; ++qt) {
                float ls = lsum[qt];
                { auto rr = __builtin_amdgcn_permlane32_swap(__builtin_bit_cast(unsigned, ls), __builtin_bit_cast(unsigned, ls), false, false); ls = __builtin_bit_cast(float, rr[0]) + __builtin_bit_cast(float, rr[1]); }
                const float inv = frcp(ls);
                unsigned char* op = att8 + ((size_t)b * SEQ + qb * 512 + wave * 64 + qt * 32 + l31q) * 512 + hd * 64;
                const float inv8 = 8.f * inv;
#pragma unroll
                for (int dt = 0; dt < 2; ++dt)
#pragma unroll
                    for (int i4 = 0; i4 < 4; ++i4) {
                        const int d = dt * 32 + 8 * i4 + 4 * hhq;
                        float e4[4];
#pragma unroll
                        for (int q = 0; q < 4; ++q) e4[q] = fminf(fmaxf(o[qt][dt][4 * i4 + q] * inv8, -448.f), 448.f);
                        int w8 = __builtin_amdgcn_cvt_pk_fp8_f32(e4[0], e4[1], 0, false); w8 = __builtin_amdgcn_cvt_pk_fp8_f32(e4[2], e4[3], w8, true);
                        *(int*)(op + d) = w8;
                    }
            }
#undef ATT_GLOAD
#undef ATT_LWRITE
        }
        __syncthreads();
    }

#define SCAN_ROW(g) (((g) < CTX) ? (NL + b * CTX + (dir ? (CTX - 1 - (g)) : (g))) : (b * SEQ + (dir ? (SEQ - 1 - ((g) - CTX)) : ((g) - CTX))))
    if (IN(6)) {
        constexpr int PITCH = 144, IMG = 32 * PITCH, SLOT = 4 * IMG;
        constexpr int GAM_OFF = 7 * SLOT, XT_OFF = GAM_OFF + 14 * 256, XP = 144, XB = 64 * XP, XV_OFF = XT_OFF + 2 * XB, FLG_OFF = XV_OFF + 2 * 32 * 144;
        static_assert(FLG_OFF + 64 <= LDS_MISC, "fused scan LDS map");
        volatile LAS int* flg = (volatile LAS int*)(lds + FLG_OFF);
        for (int sid = bid; sid < 256; sid += G) {
            const int dir = sid & 1, hd = (sid >> 1) & 7, b = sid >> 4;
            __syncthreads();
            { int tid_ = tid; asm volatile("" : "+v"(tid_));
              if (tid_ < 16) flg[tid_] = 0;
              *(LAS u32x4*)(lds + XT_OFF + (tid_ >> 3) * XP + (tid_ & 7) * 16) = (u32x4){0u, 0u, 0u, 0u}; }
            __syncthreads();
            if (wave < 7) {
                int lane_ = lane; asm volatile("" : "+v"(lane_));
                const int l31_ = lane_ & 31, hh_ = lane_ >> 5;
                LAS unsigned char* wl = lds + wave * SLOT;
                const int blk = (lane_ >> 4) & 1, q_ = (lane_ & 15) >> 2, p_ = lane_ & 3;
                bf16x8 If[2];
#pragma unroll
                for (int st = 0; st < 2; ++st)
#pragma unroll
                    for (int j = 0; j < 8; ++j) If[st][j] = (((j & 3) + 16 * st + 8 * (j >> 2) + 4 * hh_) == l31_) ? (short)0x3F80 : (short)0;
#define ROWI(i) (((i) & 3) + 8 * ((i) >> 2) + 4 * hh_)
#define PACKA(acc, st) __builtin_bit_cast(bf16x8, (u32x4){pk2((acc)[8 * (st)], (acc)[8 * (st) + 1]), pk2((acc)[8 * (st) + 2], (acc)[8 * (st) + 3]), pk2((acc)[8 * (st) + 4], (acc)[8 * (st) + 5]), pk2((acc)[8 * (st) + 6], (acc)[8 * (st) + 7])})
#define MM2(D, A0, A1, B0, B1, Cin) do { D = __builtin_amdgcn_mfma_f32_32x32x16_bf16(A0, B0, Cin, 0, 0, 0); D = __builtin_amdgcn_mfma_f32_32x32x16_bf16(A1, B1, D, 0, 0, 0); } while (0)
#define TRF(dst, img, st, tile) do { const LAS unsigned char* a_ = wl + (img) * IMG + (16 * (st) + 4 * hh_ + q_) * PITCH + (32 * (tile) + 16 * blk + 4 * p_) * 2; \
            const v4i16_t lo_ = __builtin_amdgcn_ds_read_tr16_b64_v4i16((LAS v4i16_t*)a_), hi_ = __builtin_amdgcn_ds_read_tr16_b64_v4i16((LAS v4i16_t*)(a_ + 8 * PITCH)); \
            dst = (bf16x8){lo_[0], lo_[1], lo_[2], lo_[3], hi_[0], hi_[1], hi_[2], hi_[3]}; } while (0)
                const f32x16 z16 = {0.f, 0.f, 0.f, 0.f, 0.f, 0.f, 0.f, 0.f, 0.f, 0.f, 0.f, 0.f, 0.f, 0.f, 0.f, 0.f};
                for (int c = wave; c < NCHUNK; c += 7) {
                    const int g = c * 32 + l31_;
                    const size_t row = (size_t)SCAN_ROW(g);
                    bf16x8 Af[4], Rf[4], Bhf[4], Khf[4];
#pragma unroll
                    for (int ks = 0; ks < 4; ++ks) {
                        const int ch = hd * 64 + 16 * ks + 8 * hh_;
                        f32x4 zw[2], za[2], kv[2], kk[2], rv[2];
                        unpack8u(*(const u32x2*)(zbuf8 + (size_t)dir * ZDIR + row * 1024 + ch), zw[0], zw[1]); unpack8u(*(const u32x2*)(zbuf8 + (size_t)dir * ZDIR + row * 1024 + 512 + ch), za[0], za[1]);
                        unpack8(*(const u32x4*)(kbuf + row * 512 + ch), kv[0], kv[1]); unpack8(*(const u32x4*)(kkbuf + row * 512 + ch), kk[0], kk[1]); unpack8(*(const u32x4*)(rbuf + row * 512 + ch), rv[0], rv[1]);
                        f32x4 At[2], Rt[2], Bh[2], Kh[2], ev[2];
#pragma unroll
                        for (int n = 0; n < 2; ++n) {
                            const f32x4 kav = *(const f32x4*)(args.in[22] + ch + 4 * n);
#pragma unroll
                            for (int q = 0; q < 4; ++q) {
                                const float lw = (-0.6065306597126334f / 255.f) * zw[n][q];
                                const float a = za[n][q] * (1.f / 255.f);
                                float Gs = lw;
                                Gs += dpp_f<0x111>(Gs); Gs += dpp_f<0x112>(Gs); Gs += dpp_f<0x114>(Gs); Gs += dpp_f<0x118>(Gs);
                                Gs += __builtin_bit_cast(float, __builtin_amdgcn_update_dpp(0, __builtin_bit_cast(int, Gs), 0x142, 0xA, 0xF, false));
                                const float e = fexp(Gs), einv = frcp(e);
                                float ep = __builtin_bit_cast(float, __builtin_amdgcn_update_dpp(0, __builtin_bit_cast(int, e), 0x138, 0xF, 0xF, false));
                                ep = (l31_ == 0) ? 1.f : ep;
                                const float beta = kk[n][q] * a, kd = kv[n][q] * (1.f + (a - 1.f) * kav[q]);
                                At[n][q] = -kk[n][q] * ep; Rt[n][q] = rv[n][q] * e; Bh[n][q] = beta * einv; Kh[n][q] = kd * einv; ev[n][q] = e;
                            }
                        }
                        const u32x4 pa = pack8(At[0], At[1]), pr = pack8(Rt[0], Rt[1]), pb = pack8(Bh[0], Bh[1]), pk = pack8(Kh[0], Kh[1]);
                        Af[ks] = __builtin_bit_cast(bf16x8, pa); Rf[ks] = __builtin_bit_cast(bf16x8, pr); Bhf[ks] = __builtin_bit_cast(bf16x8, pb); Khf[ks] = __builtin_bit_cast(bf16x8, pk);
                        if (l31_ == 31) { LAS float* gp = (LAS float*)(lds + GAM_OFF + (wave * 2 + ((c / 7) & 1)) * 256) + 16 * ks + 8 * hh_; *(LAS f32x4*)gp = ev[0]; *(LAS f32x4*)(gp + 4) = ev[1]; }
                    }
                    if (c >= 7) { unsigned sp = 0; while (flg[8 + wave] != c - 7 + 1) { __builtin_amdgcn_s_sleep(1); if (++sp > (1u << 22)) break; } }
                    asm volatile("" ::: "memory");
#pragma unroll
                    for (int ks = 0; ks < 4; ++ks) {
                        LAS unsigned char* ip = wl + l31_ * PITCH + (16 * ks + 8 * hh_) * 2;
                        *(LAS bf16x8*)(ip) = Af[ks]; *(LAS bf16x8*)(ip + IMG) = Rf[ks]; *(LAS bf16x8*)(ip + 2 * IMG) = Bhf[ks]; *(LAS bf16x8*)(ip + 3 * IMG) = Khf[ks];
                    }
                    f32x16 X = z16, XT = z16, aN = z16, aPT = z16, aQT = z16;
#pragma unroll
                    for (int ks = 0; ks < 4; ++ks) {
                        X = __builtin_amdgcn_mfma_f32_32x32x16_bf16(Af[ks], Bhf[ks], X, 0, 0, 0);
                        XT = __builtin_amdgcn_mfma_f32_32x32x16_bf16(Bhf[ks], Af[ks], XT, 0, 0, 0);
                        aN = __builtin_amdgcn_mfma_f32_32x32x16_bf16(Af[ks], Khf[ks], aN, 0, 0, 0);
                        aPT = __builtin_amdgcn_mfma_f32_32x32x16_bf16(Bhf[ks], Rf[ks], aPT, 0, 0, 0);
                        aQT = __builtin_amdgcn_mfma_f32_32x32x16_bf16(Khf[ks], Rf[ks], aQT, 0, 0, 0);
                    }
                    f32x16 Pr, PrT;
#pragma unroll
                    for (int i = 0; i < 16; ++i) { const int ri = ROWI(i);
                        X[i] = (l31_ < ri) ? X[i] : 0.f; aN[i] = (l31_ < ri) ? aN[i] : 0.f;
                        XT[i] = (ri < l31_) ? XT[i] : 0.f;
                        aPT[i] = (ri <= l31_) ? aPT[i] : 0.f; aQT[i] = (ri <= l31_) ? aQT[i] : 0.f;
                        const float idv = (ri == l31_) ? 1.f : 0.f; Pr[i] = X[i] + idv; PrT[i] = XT[i] + idv; }
#pragma unroll
                    for (int lv = 0; lv < 4; ++lv) {
                        const bf16x8 x0 = PACKA(X, 0), x1 = PACKA(X, 1), t0 = PACKA(XT, 0), t1 = PACKA(XT, 1);
                        f32x16 X2, XT2 = z16; MM2(X2, t0, t1, x0, x1, z16);
                        if (lv < 3) MM2(XT2, x0, x1, t0, t1, z16);
                        const bf16x8 p0 = PACKA(PrT, 0), p1 = PACKA(PrT, 1), y0 = PACKA(X2, 0), y1 = PACKA(X2, 1);
                        MM2(Pr, p0, p1, y0, y1, Pr);
                        MM2(PrT, y0, y1, p0, p1, PrT);
                        X = X2; XT = XT2;
                    }
                    bf16x8 trA[2][2], trR[2][2], trB[2][2], trK[2][2];
#pragma unroll
                    for (int x = 0; x < 2; ++x) { TRF(trA[x][0], 0, 0, x); TRF(trA[x][1], 0, 1, x); TRF(trR[x][0], 1, 0, x); TRF(trR[x][1], 1, 1, x); TRF(trB[x][0], 2, 0, x); TRF(trB[x][1], 2, 1, x); TRF(trK[x][0], 3, 0, x); TRF(trK[x][1], 3, 1, x); }
                    asm volatile("s_waitcnt lgkmcnt(0)" ::: "memory");
                    const bf16x8 tt0 = PACKA(Pr, 0), tt1 = PACKA(Pr, 1), n0 = PACKA(aN, 0), n1 = PACKA(aN, 1);
                    f32x16 PpT; { const bf16x8 b0 = PACKA(aPT, 0), b1 = PACKA(aPT, 1); MM2(PpT, tt0, tt1, b0, b1, z16); }
                    const bf16x8 pp0 = PACKA(PpT, 0), pp1 = PACKA(PpT, 1);
                    LAS unsigned char* Lrow1 = wl + l31_ * 192; const int lsw = (l31_ >> 1) & 7;
#define LSTORE(rowp, col0, w) (*(LAS u32x2*)((rowp) + ((((col0) >> 2) ^ lsw) << 3)) = (w))
                    {
                        f32x16 YT; MM2(YT, n0, n1, pp0, pp1, aQT);
#pragma unroll
                        for (int i4 = 0; i4 < 4; ++i4) { u32x2 w; w.x = pk2(YT[4 * i4], YT[4 * i4 + 1]); w.y = pk2(YT[4 * i4 + 2], YT[4 * i4 + 3]); LSTORE(Lrow1, 64 + 8 * i4 + 4 * hh_, w); }
                    }
#pragma unroll
                    for (int rt = 0; rt < 2; ++rt) {
                        f32x16 RT; MM2(RT, trA[rt][0], trA[rt][1], pp0, pp1, z16); MM2(RT, trR[rt][0], trR[rt][1], If[0], If[1], RT);
#pragma unroll
                        for (int i4 = 0; i4 < 4; ++i4) { u32x2 w; w.x = pk2(RT[4 * i4], RT[4 * i4 + 1]); w.y = pk2(RT[4 * i4 + 2], RT[4 * i4 + 3]); LSTORE(Lrow1, 32 * rt + 8 * i4 + 4 * hh_, w); }
                    }
#pragma unroll
                    for (int ct = 0; ct < 2; ++ct) {
                        f32x16 Bpp; MM2(Bpp, tt0, tt1, trB[ct][0], trB[ct][1], z16);
                        const bf16x8 bb0 = PACKA(Bpp, 0), bb1 = PACKA(Bpp, 1);
                        LAS unsigned char* Lrow2 = wl + (32 + 32 * ct + l31_) * 192;
#pragma unroll
                        for (int rt = 0; rt < 2; ++rt) {
                            f32x16 GT; MM2(GT, trA[rt][0], trA[rt][1], bb0, bb1, z16);
#pragma unroll
                            for (int i4 = 0; i4 < 4; ++i4) { u32x2 w; w.x = pk2(GT[4 * i4], GT[4 * i4 + 1]); w.y = pk2(GT[4 * i4 + 2], GT[4 * i4 + 3]); LSTORE(Lrow2, 32 * rt + 8 * i4 + 4 * hh_, w); }
                        }
                        f32x16 HT; MM2(HT, n0, n1, bb0, bb1, z16); MM2(HT, If[0], If[1], trK[ct][0], trK[ct][1], HT);
#pragma unroll
                        for (int i4 = 0; i4 < 4; ++i4) { u32x2 w; w.x = pk2(HT[4 * i4], HT[4 * i4 + 1]); w.y = pk2(HT[4 * i4 + 2], HT[4 * i4 + 3]); LSTORE(Lrow2, 64 + 8 * i4 + 4 * hh_, w); }
                    }
                    asm volatile("s_waitcnt lgkmcnt(0)" ::: "memory");
                    if (lane_ == 0) flg[wave] = c + 1;
                }
#undef LSTORE
#undef TRF
#undef MM2
#undef PACKA
#undef ROWI
            } else {
                int lane_ = lane; asm volatile("" : "+v"(lane_));
                const int l31_ = lane_ & 31, hh_ = lane_ >> 5;
                const int n_ = lane_ & 15, g4 = lane_ >> 4;
                f32x4 Zr[4][4];
#pragma unroll
                for (int zt = 0; zt < 4; ++zt)
#pragma unroll
                    for (int ct = 0; ct < 4; ++ct) Zr[zt][ct] = (f32x4){0.f, 0.f, 0.f, 0.f};
                u32x4 vpre[4];
                constexpr int VP = 144;
#define FS_VLOAD(cc) do { const int g_ = (cc) * 32 + l31_; const bf16_t* vp_ = vbuf + (size_t)SCAN_ROW(g_) * 512 + hd * 64 + 32 * hh_; \
                    _Pragma("unroll") for (int i = 0; i < 4; ++i) vpre[i] = *(const u32x4*)(vp_ + 8 * i); } while (0)
#define FS_VWRITE(buf) do { LAS unsigned char* d_ = lds + XV_OFF + (buf) * (32 * VP) + l31_ * VP + 64 * hh_; \
                    _Pragma("unroll") for (int i = 0; i < 4; ++i) *(LAS u32x4*)(d_ + 16 * i) = vpre[i]; } while (0)
                FS_VLOAD(0); FS_VWRITE(0); FS_VLOAD(1);
                const int tq_ = (lane_ & 15) >> 2, tp_ = lane_ & 3;
                for (int c = 0; c < NCHUNK; ++c) {
                    const int slot = c % 7;
                    { unsigned sp = 0; while (flg[slot] != c + 1) { __builtin_amdgcn_s_sleep(1); if (++sp > (1u << 22)) break; } }
                    asm volatile("" ::: "memory");
                    const LAS unsigned char* Ls = lds + slot * SLOT;
                    const LAS unsigned char* xc = lds + XT_OFF + (c & 1) * XB + n_ * XP + 16 * g4;
                    LAS unsigned char* xn = lds + XT_OFF + ((c + 1) & 1) * XB;
                    bf16x8 bfr[4][3];
#pragma unroll
                    for (int ct = 0; ct < 4; ++ct) {
#pragma unroll
                        for (int ks = 0; ks < 2; ++ks) bfr[ct][ks] = *(const LAS bf16x8*)(xc + 16 * ct * XP + 64 * ks);
                        const LAS unsigned char* va = lds + XV_OFF + (c & 1) * (32 * VP) + (8 * g4 + tq_) * VP + (16 * ct + 4 * tp_) * 2;
                        const v4i16_t lo_ = __builtin_amdgcn_ds_read_tr16_b64_v4i16((LAS v4i16_t*)va), hi_ = __builtin_amdgcn_ds_read_tr16_b64_v4i16((LAS v4i16_t*)(va + 4 * VP));
                        bfr[ct][2] = (bf16x8){lo_[0], lo_[1], lo_[2], lo_[3], hi_[0], hi_[1], hi_[2], hi_[3]};
                    }
                    const bool emit = c >= CTX / 32;
                    const int gg0 = c * 32; const int tl0 = dir ? (SEQ - 1 - (gg0 - CTX)) : (gg0 - CTX); const int ysg = dir ? -512 : 512;
                    bf16_t* ych = ybuf + ((size_t)dir * NL + b * SEQ + (emit ? tl0 : 0)) * 512 + hd * 64;
#pragma unroll
                    for (int rt = 0; rt < 6; ++rt) {
                        if (rt < 2 && !emit) continue;
                        bf16x8 afr[3];
#pragma unroll
                        for (int ks = 0; ks < 3; ++ks) { const LAS unsigned char* rp_ = Ls + (16 * rt + n_) * 192; const int cg_ = 8 * ks + 2 * g4, sw_ = (n_ >> 1) & 7;
                            const u32x2 lo_ = *(const LAS u32x2*)(rp_ + ((cg_ ^ sw_) << 3)), hi_ = *(const LAS u32x2*)(rp_ + (((cg_ + 1) ^ sw_) << 3));
                            afr[ks] = __builtin_bit_cast(bf16x8, (u32x4){lo_.x, lo_.y, hi_.x, hi_.y}); }
                        f32x4 gm = {0.f, 0.f, 0.f, 0.f};
                        if (rt >= 2) gm = *(const LAS f32x4*)(lds + GAM_OFF + (slot * 2 + ((c / 7) & 1)) * 256 + (16 * (rt - 2) + 4 * g4) * 4);
#pragma unroll
                        for (int ct = 0; ct < 4; ++ct) {
                            f32x4 acc = {0.f, 0.f, 0.f, 0.f};
                            if (rt >= 2) acc = Zr[rt >= 2 ? rt - 2 : 0][ct];
                            if (rt >= 2) {
#pragma unroll
                                for (int ks = 0; ks < 3; ++ks) acc = __builtin_amdgcn_mfma_f32_16x16x32_bf16(afr[ks], bfr[ct][ks], acc, 0, 0, 0);
                            } else {
#pragma unroll
                                for (int ks = 0; ks < 3; ++ks) acc = __builtin_amdgcn_mfma_f32_16x16x32_bf16(bfr[ct][ks], afr[ks], acc, 0, 0, 0);
                            }
                            if (rt >= 2) {
                                acc = acc * gm;
                                Zr[rt >= 2 ? rt - 2 : 0][ct] = acc;
                                u32x2 w; w.x = pk2(acc[0], acc[1]); w.y = pk2(acc[2], acc[3]);
                                *(LAS u32x2*)(xn + (16 * ct + n_) * XP + (16 * (rt - 2) + 4 * g4) * 2) = w;
                            } else {
                                u32x2 w; w.x = pk2(acc[0], acc[1]); w.y = pk2(acc[2], acc[3]);
                                *(u32x2*)(ych + (16 * rt + n_) * ysg + 16 * ct + 4 * g4) = w;
                            }
                        }
                    }
                    asm volatile("s_waitcnt lgkmcnt(0)" ::: "memory");
                    if (lane_ == 0) flg[8 + slot] = c + 1;
                    if (c + 1 < NCHUNK) FS_VWRITE((c + 1) & 1);
                    if (c + 2 < NCHUNK) FS_VLOAD(c + 2);
                    asm volatile("s_waitcnt lgkmcnt(0)" ::: "memory");
                }
#undef FS_VLOAD
#undef FS_VWRITE
            }
        }
        if (BOTH(6)) GRID_BAR();
    }
#undef SCAN_ROW

    if (IN(7)) {
        const float* r_k = args.in[23]; const float* gn_w = args.in[24]; const float* gn_b = args.in[25]; const float* a0 = args.in[19]; const float* k_a = args.in[22];
        const int c = lane * 8;
        const f32x4 ka0 = *(const f32x4*)(k_a + c), ka1 = *(const f32x4*)(k_a + c + 4), rk0 = *(const f32x4*)(r_k + c), rk1 = *(const f32x4*)(r_k + c + 4);
        const f32x4 gw0 = *(const f32x4*)(gn_w + c), gw1 = *(const f32x4*)(gn_w + c + 4), gb0 = *(const f32x4*)(gn_b + c), gb1 = *(const f32x4*)(gn_b + c + 4);
        for (int rowp = vcu * 8 + wave; rowp < NL / 2; rowp += G * 8) {
            u32x4 in_[2][8];
#pragma unroll
            for (int rr = 0; rr < 2; ++rr) { const size_t row = (size_t)rowp * 2 + rr;
                in_[rr][0] = *(const u32x4*)(ybuf + row * 512 + c); in_[rr][1] = *(const u32x4*)(ybuf + ((size_t)NL + row) * 512 + c);
                in_[rr][2] = *(const u32x4*)(rbuf + row * 512 + c); in_[rr][3] = *(const u32x4*)(kbuf + row * 512 + c); in_[rr][4] = *(const u32x4*)(vbuf + row * 512 + c);
                { const u32x2 zf_ = *(const u32x2*)(zbuf8 + row * 1024 + 512 + c), zb_ = *(const u32x2*)(zbuf8 + ZDIR + row * 1024 + 512 + c); in_[rr][5] = (u32x4){zf_.x, zf_.y, 0u, 0u}; in_[rr][6] = (u32x4){zb_.x, zb_.y, 0u, 0u}; }
                in_[rr][7] = *(const u32x4*)(gbuf + row * 512 + c); }
#pragma unroll
            for (int rr = 0; rr < 2; ++rr) { const size_t row = (size_t)rowp * 2 + rr;
                f32x4 ya0, ya1, yb0, yb1, r0, r1, k0, k1, v0, v1, zf0, zf1, zb0, zb1, g0, g1;
                unpack8(in_[rr][0], ya0, ya1); unpack8(in_[rr][1], yb0, yb1); unpack8(in_[rr][2], r0, r1); unpack8(in_[rr][3], k0, k1); unpack8(in_[rr][4], v0, v1);
                unpack8u((u32x2){in_[rr][5].x, in_[rr][5].y}, zf0, zf1); unpack8u((u32x2){in_[rr][6].x, in_[rr][6].y}, zb0, zb1); unpack8(in_[rr][7], g0, g1);
                zf0 = zf0 * (1.f / 255.f); zf1 = zf1 * (1.f / 255.f); zb0 = zb0 * (1.f / 255.f); zb1 = zb1 * (1.f / 255.f);
                const f32x4 y0 = ya0 + yb0, y1 = ya1 + yb1;
                float sum = 0.f, dot = 0.f;
#pragma unroll
                for (int q = 0; q < 4; ++q) {
                    sum += y0[q] + y1[q];
                    const float as0 = zf0[q] + zb0[q], as1 = zf1[q] + zb1[q];
                    dot += r0[q] * k0[q] * (2.f + (as0 - 2.f) * ka0[q]) * rk0[q] + r1[q] * k1[q] * (2.f + (as1 - 2.f) * ka1[q]) * rk1[q];
                }
                sum += dpp_f<0xB1>(sum); sum += dpp_f<0x4E>(sum); sum += dpp_f<0x141>(sum);
                dot += dpp_f<0xB1>(dot); dot += dpp_f<0x4E>(dot); dot += dpp_f<0x141>(dot);
                const float mu = sum * (1.f / 64.f);
                const f32x4 d0 = y0 - mu, d1 = y1 - mu;
                float var = d0[0] * d0[0] + d0[1] * d0[1] + d0[2] * d0[2] + d0[3] * d0[3] + d1[0] * d1[0] + d1[1] * d1[1] + d1[2] * d1[2] + d1[3] * d1[3];
                var += dpp_f<0xB1>(var); var += dpp_f<0x4E>(var); var += dpp_f<0x141>(var);
                const float rs = rsqrtf(var * (1.f / 64.f) + GN_EPS);
                const f32x4 o0 = (d0 * rs * gw0 + gb0 + v0 * dot) * g0, o1 = (d1 * rs * gw1 + gb1 + v1 * dot) * g1;
                float e8[8];
#pragma unroll
                for (int q = 0; q < 4; ++q) { e8[q] = fminf(fmaxf(8.f * o0[q], -448.f), 448.f); e8[4 + q] = fminf(fmaxf(8.f * o1[q], -448.f), 448.f); }
                int wlo = __builtin_amdgcn_cvt_pk_fp8_f32(e8[0], e8[1], 0, false); wlo = __builtin_amdgcn_cvt_pk_fp8_f32(e8[2], e8[3], wlo, true);
                int whi = __builtin_amdgcn_cvt_pk_fp8_f32(e8[4], e8[5], 0, false); whi = __builtin_amdgcn_cvt_pk_fp8_f32(e8[6], e8[7], whi, true);
                *(u32x2*)(rwout8 + row * 512 + c) = (u32x2){(unsigned)wlo, (unsigned)whi};
            }
        }
        if (BOTH(7)) GRID_BAR();
    }

    if (IN(8)) {
        pg8::SchedTiles S{vcu, G, 1}; EpiMerge E{gates8, merged8}; pg8::ATwo AO{(unsigned)(rwout8 - att8)};
        pg8::gemm_phase<EpiMerge, pg8::SchedTiles, pg8::ATwo, true, true, false, 0, true, true>(lds, (const char*)att8, (const char*)Wo_t8, k256, S, E, AO);
        if (BOTH(8)) GRID_BAR();
    }

    bf16_t* x1b = (bf16_t*)(ws + WS_X1B);
    if (IN(9)) {
        pg8::SchedTiles S{vcu, G, 0}; EpiOut E{x_in, mod, x1b}; pg8::APlain AO;
        pg8::gemm_phase<EpiOut, pg8::SchedTiles, pg8::APlain, true, true, false, 0, true>(lds, (const char*)merged8, (const char*)Wout_t8, 2 * k256, S, E, AO);
        if (BOTH(9)) GRID_BAR();
    }

    bf16_t* ubuf = (bf16_t*)(ws + WS_U);
    float* scores = (float*)(ws + WS_SCORE);
    int* top_e = (int*)(ws + WS_TOPE); int* top_p = (int*)(ws + WS_TOPP);
    int* ltok = (int*)(ws + WS_LTOK); float* lgate = (float*)(ws + WS_LGATE);
    unsigned char* hb = ws + WS_HB; unsigned char* yb = ws + WS_YB; unsigned char* u8 = ws + WS_U8;
    unsigned* ecnt = ctl + CW_CNT;
    if (IN(10)) {
        const float* nffn = args.in[7];
        for (int row = bid * 8 + wave; row < NL; row += G * 8) {
            const bf16_t* xr = x1b + (size_t)row * D;
            const float* mrow = mod + (row >> 11) * 6144;
            f32x4 v[4]; float ss = 0.f;
#pragma unroll
            for (int i = 0; i < 4; ++i) { const u32x2 w_ = *(const u32x2*)(xr + lane * 4 + 256 * i); v[i] = (f32x4){bflo(w_.x), bfhi(w_.x), bflo(w_.y), bfhi(w_.y)}; ss += v[i][0] * v[i][0] + v[i][1] * v[i][1] + v[i][2] * v[i][2] + v[i][3] * v[i][3]; }
            ss = wave_sum(ss);
            const float rstd = rsqrtf(ss * (1.f / D) + EPS);
#pragma unroll
            for (int i = 0; i < 4; ++i) {
                const int c = lane * 4 + 256 * i;
                const f32x4 g = *(const f32x4*)(nffn + c), sh = *(const f32x4*)(mrow + 3072 + c), sc = *(const f32x4*)(mrow + 4096 + c);
                f32x4 y = v[i] * rstd * g * (sc + 1.f) + sh;
                u32x2 o; o.x = pk2(y[0], y[1]); o.y = pk2(y[2], y[3]);
                *(u32x2*)(ubuf + (size_t)row * D + c) = o;
#pragma unroll
                for (int q = 0; q < 4; ++q) y[q] = fminf(fmaxf(4.f * y[q], -448.f), 448.f);
                int w8 = __builtin_amdgcn_cvt_pk_fp8_f32(y[0], y[1], 0, false); w8 = __builtin_amdgcn_cvt_pk_fp8_f32(y[2], y[3], w8, true);
                *(int*)(u8 + (size_t)row * D + c) = w8;
            }
        }
        if (BOTH(10)) GRID_BAR();
    }

    if (IN(11)) {
        pg8::SchedRouter S{vcu, G}; EpiRouter E{scores}; pg8::APlain AO;
        pg8::gemm_phase<EpiRouter, pg8::SchedRouter, pg8::APlain, false>(lds, (const char*)ubuf, (const char*)Wr_t, D, S, E, AO);
        {
            LAS float* scr = (LAS float*)(lds + wave * 8448);
            unsigned* qhead = ctl + CW_CNT + 512;
            const int cni = 36 * ((NB * 8 * 4) / G), cW = G * 8, cR_ = ((CONV_ITEMS + cW - 1) / cW) * 7 / 8, cR = cR_ < cni - 1 ? cR_ : cni - 1;
            const unsigned first = (unsigned)cR * (unsigned)cW;
            for (;;) {
                unsigned base = 0;
                if (lane == 0) base = __hip_atomic_fetch_add(qhead, 16u, __ATOMIC_RELAXED, __HIP_MEMORY_SCOPE_AGENT);
                base = __builtin_amdgcn_readfirstlane(base) + first;
                if (base >= (unsigned)CONV_ITEMS) break;
                for (int it = (int)base; it < (int)base + 16 && it < CONV_ITEMS; ++it) {
                    const float* src; unsigned char* dst; int Nn, Kb; float sc;
                    conv_decode(it, args.in, W13t8, W2t8, src, Nn, dst, Kb, sc);
                    transpose_block_f8(src, Nn, dst, Kb, scr, lane, sc);
                }
            }
        }
        if (BOTH(11)) GRID_BAR();
    }

    if (IN(12)) {
        const float* rbias = args.in[30];
        LAS int* lcnt = (LAS int*)lds;
        LAS int* le = lcnt + 256;
        LAS int* lp = le + 1024;
        LAS float* lg = (LAS float*)(lp + 1024);
        for (int tb = bid * 128; tb < NL; tb += G * 128) {
            __syncthreads();
            if (tid < 256) lcnt[tid] = 0;
            __syncthreads();
            const f32x4 bv = *(const f32x4*)(rbias + lane * 4);
            f32x4 scn = *(const f32x4*)(scores + (size_t)(tb + wave * 16) * 256 + lane * 4);
            for (int it = 0; it < 16; ++it) {
                const int tl = wave * 16 + it, tok = tb + tl;
                const f32x4 sc = scn;
                if (it + 1 < 16) scn = *(const f32x4*)(scores + (size_t)(tok + 1) * 256 + lane * 4);
                float sel[4] = {sc[0] + bv[0], sc[1] + bv[1], sc[2] + bv[2], sc[3] + bv[3]};
                float m1 = fmaxf(sel[0], sel[1]), m2 = fminf(sel[0], sel[1]);
                { const float a = fmaxf(sel[2], sel[3]), bq = fminf(sel[2], sel[3]); const float n1 = fmaxf(m1, a); m2 = fmaxf(fminf(m1, a), fmaxf(m2, bq)); m1 = n1; }
#pragma unroll
#define TOP2_STEP(CTRL) do { const float a = dpp_f<CTRL>(m1), bq = dpp_f<CTRL>(m2); const float n1 = fmaxf(m1, a); m2 = fmaxf(fminf(m1, a), fmaxf(m2, bq)); m1 = n1; } while (0)
                TOP2_STEP(0xB1); TOP2_STEP(0x4E); TOP2_STEP(0x141);
#undef TOP2_STEP
                const float gs = m1 + m2; const int grp = lane >> 3;
                int rank = 0;
#pragma unroll
                for (int g2 = 0; g2 < 8; ++g2) { const float og = __builtin_bit_cast(float, __builtin_amdgcn_readlane(__builtin_bit_cast(int, gs), g2 * 8)); rank += (og > gs || (og == gs && g2 < grp)) ? 1 : 0; }
                if (rank >= 4) { sel[0] = sel[1] = sel[2] = sel[3] = -INFINITY; }
                unsigned vb[4];
#pragma unroll
                for (int q = 0; q < 4; ++q) { const unsigned b_ = __builtin_bit_cast(unsigned, sel[q]); vb[q] = b_ ^ ((unsigned)((int)b_ >> 31) | 0x80000000u); }
                unsigned thr = 0u;
#pragma unroll 1
                for (int bit = 31; bit >= 0; --bit) {
                    const unsigned cand = thr | (1u << bit);
                    const int cnt = __builtin_popcountll(__ballot(vb[0] >= cand)) + __builtin_popcountll(__ballot(vb[1] >= cand)) + __builtin_popcountll(__ballot(vb[2] >= cand)) + __builtin_popcountll(__ballot(vb[3] >= cand));
                    if (cnt >= TOPK) thr = cand;
                    if (cnt == TOPK) break;
                }
                const unsigned long long below = (lane == 0) ? 0ull : (~0ull >> (64 - lane));
                unsigned long long bg[4], bt[4]; int ngt = 0;
#pragma unroll
                for (int q = 0; q < 4; ++q) { bg[q] = __ballot(vb[q] > thr); bt[q] = __ballot(vb[q] == thr); ngt += __builtin_popcountll(bg[q]); }
                const int need = TOPK - ngt;
                float gsum = 0.f;
                int selk[4];
                {
                    int tie_before = 0, gt_before = 0;
#pragma unroll
                    for (int q = 0; q < 4; ++q) { tie_before += __builtin_popcountll(bt[q] & below); gt_before += __builtin_popcountll(bg[q] & below); }
                    int tsel_before = tie_before < need ? tie_before : need;
                    int pos = gt_before + tsel_before;
                    int tb = tie_before;
#pragma unroll
                    for (int q = 0; q < 4; ++q) {
                        const bool isg = vb[q] > thr, ist = (vb[q] == thr) && (tb < need);
                        selk[q] = (isg || ist) ? pos : -1;
                        pos += (isg || ist) ? 1 : 0; tb += (vb[q] == thr) ? 1 : 0;
                    }
                }
                float ssum = 0.f;
#pragma unroll
                for (int q = 0; q < 4; ++q) ssum += (selk[q] >= 0) ? sc[q] : 0.f;
                { float v_ = ssum; v_ += dpp_f<0xB1>(v_); v_ += dpp_f<0x4E>(v_); v_ += dpp_f<0x141>(v_); v_ += dpp_f<0x140>(v_);
                  const int vi_ = __builtin_bit_cast(int, v_);
                  gsum = (__builtin_bit_cast(float, __builtin_amdgcn_readlane(vi_, 0)) + __builtin_bit_cast(float, __builtin_amdgcn_readlane(vi_, 16))) + (__builtin_bit_cast(float, __builtin_amdgcn_readlane(vi_, 32)) + __builtin_bit_cast(float, __builtin_amdgcn_readlane(vi_, 48))); }
#pragma unroll
                for (int q = 0; q < 4; ++q) if (selk[q] >= 0) {
                    const int my_e = lane * 4 + q;
                    const int p = atomicAdd((int*)&lcnt[my_e], 1);
                    le[tl * 8 + selk[q]] = my_e; lp[tl * 8 + selk[q]] = p; lg[tl * 8 + selk[q]] = sc[q] / gsum * 2.5f;
                }
            }
            __syncthreads();
            if (tid < 256) { const int c = lcnt[tid]; lcnt[tid] = c ? (int)atomicAdd(&ecnt[tid], (unsigned)c) : 0; }
            __syncthreads();
            for (int i = tid; i < 1024; i += NTHREADS) {
                const int e = le[i], p = lcnt[e] + lp[i], tok = tb + (i >> 3);
                top_e[(size_t)tok * 8 + (i & 7)] = e; top_p[(size_t)tok * 8 + (i & 7)] = p;
                ltok[(size_t)e * NL + p] = tok; lgate[(size_t)e * NL + p] = lg[i];
            }
        }
        if (BOTH(12)) GRID_BAR();
    }

    LAS int* eoff = (LAS int*)(lds + LDS_EOFF);
    LAS int* toff = eoff + 260;
    if (lo <= 15 && hi > 13) {
        __syncthreads();
        if (tid < 64) {
            int c[4], t[4]; int cs = 0, tsum = 0;
#pragma unroll
            for (int j = 0; j < 4; ++j) { c[j] = (int)__hip_atomic_load(&ecnt[lane * 4 + j], __ATOMIC_RELAXED, __HIP_MEMORY_SCOPE_AGENT); t[j] = (c[j] + 255) >> 8; cs += c[j]; tsum += t[j]; }
            int ics = cs, its = tsum;
#pragma unroll
            for (int o = 1; o < 64; o <<= 1) { const int a = __shfl_up(ics, o, 64), bq = __shfl_up(its, o, 64); if (lane >= o) { ics += a; its += bq; } }
            int ec = ics - cs, et = its - tsum;
#pragma unroll
            for (int j = 0; j < 4; ++j) { eoff[lane * 4 + j] = ec; toff[lane * 4 + j] = et; ec += c[j]; et += t[j]; }
            if (lane == 63) { eoff[256] = ec; eoff[257] = ec + NL; toff[256] = et; toff[257] = et + NL / 256; }
        }
        __syncthreads();
    }

    LAS int* ulist = toff + 264;
#define MOE_UNIT_LIST(NSH) do { __syncthreads(); if (tid < 64) { const int x_ = vcu + tid * G; if (x_ < (toff[257] << (NSH))) { const int ti_ = x_ >> (NSH); int e_ = 0; \
        if (toff[256] <= ti_) e_ = 256; else { _Pragma("unroll") for (int s_ = 128; s_ >= 1; s_ >>= 1) if (toff[e_ + s_] <= ti_) e_ += s_; } \
        const int pm_ = ti_ - toff[e_]; *(LAS i32x4*)(ulist + 4 * tid) = (i32x4){e_, pm_, eoff[e_ + 1] - eoff[e_], eoff[e_] + pm_ * 256}; } } __syncthreads(); } while (0)
    if (IN(13)) {
        MOE_UNIT_LIST(1);
        pg8::SchedMoeList S{vcu, G, toff[257] << 1, 1, ulist}; EpiUp E{hb, ws + WS_DUMMY}; pg8::AGather AO{ltok};
        pg8::gemm_phase<EpiUp, pg8::SchedMoeList, pg8::AGather, true, true, false, 8>(lds, (const char*)u8, (const char*)W13t8, 2 * k256, S, E, AO);
        if (BOTH(13)) GRID_BAR();
    }

    if (IN(14)) {
        MOE_UNIT_LIST(2);
        pg8::SchedMoeList S{vcu, G, toff[257] << 2, 2, ulist}; EpiDown E{yb, ws + WS_DUMMY}; pg8::ASlot AO;
        pg8::gemm_phase<EpiDown, pg8::SchedMoeList, pg8::ASlot, true, true, false, 8>(lds, (const char*)hb, (const char*)W2t8, k256 >> 1, S, E, AO);
        if (BOTH(14)) GRID_BAR();
    }

    if (IN(15)) {
        int nslot = 0; float ngate = 1.f / 32.f;
        { const int row0 = bid * 8 + wave;
          if (row0 < NL) { nslot = eoff[256] + row0; if (lane < 8) { const int e_ = top_e[(size_t)row0 * 8 + lane], p_ = top_p[(size_t)row0 * 8 + lane]; nslot = eoff[e_] + p_; ngate = lgate[(size_t)e_ * NL + p_] * (1.f / 32.f); } } }
        for (int row = bid * 8 + wave; row < NL; row += G * 8) {
            const float* gm = mod + (row >> 11) * 6144 + 5120;
            const int slot = nslot; const float gate = ngate;
            const int rown = row + G * 8;
            int ne_ = 0, np_ = 0;
            if (rown < NL && lane < 8) { ne_ = top_e[(size_t)rown * 8 + lane]; np_ = top_p[(size_t)rown * 8 + lane]; }
            const int cbase = (lane >> 4) * 256 + ((lane >> 2) & 3) * 32 + (lane & 3) * 8;
            f32x4 xin[2][2], gin[2][2];
#pragma unroll
            for (int i = 0; i < 2; ++i)
                { unpack8(*(const u32x4*)(x1b + (size_t)row * D + cbase + 128 * i), xin[i][0], xin[i][1]);
#pragma unroll
                  for (int q4 = 0; q4 < 2; ++q4) gin[i][q4] = *(const f32x4*)(gm + cbase + 128 * i + 4 * q4); }
            float accv[2][8];
#pragma unroll
            for (int i = 0; i < 2; ++i)
#pragma unroll
                for (int q = 0; q < 8; ++q) accv[i][q] = 0.f;
#pragma unroll
            for (int k = 0; k < 9; ++k) {
                const int sl = __builtin_amdgcn_readlane(slot, k); const float gk = __builtin_bit_cast(float, __builtin_amdgcn_readlane(__builtin_bit_cast(int, gate), k));
                const u32x4 w = *(const u32x4*)(yb + (size_t)sl * D + lane * 16);
                const unsigned ww[4] = {w.x, w.y, w.z, w.w};
#pragma unroll
                for (int i = 0; i < 2; ++i)
#pragma unroll
                    for (int h2 = 0; h2 < 2; ++h2) { const f32x2 lo = __builtin_amdgcn_cvt_pk_f32_fp8((int)ww[2 * i + h2], false), hi = __builtin_amdgcn_cvt_pk_f32_fp8((int)ww[2 * i + h2], true);
                        accv[i][4 * h2] += gk * lo[0]; accv[i][4 * h2 + 1] += gk * lo[1]; accv[i][4 * h2 + 2] += gk * hi[0]; accv[i][4 * h2 + 3] += gk * hi[1]; }
            }
            nslot = eoff[256] + rown; ngate = 1.f / 32.f;
            if (rown < NL && lane < 8) { nslot = eoff[ne_] + np_; ngate = lgate[(size_t)ne_ * NL + np_] * (1.f / 32.f); }
#pragma unroll
            for (int i = 0; i < 2; ++i) {
                float* orow = args.out + (size_t)row * D + cbase + 128 * i;
#pragma unroll
                for (int q4 = 0; q4 < 2; ++q4) {
                    f32x4 xv = xin[i][q4]; const f32x4 g = gin[i][q4];
#pragma unroll
                    for (int q = 0; q < 4; ++q) xv[q] += g[q] * accv[i][4 * q4 + q];
                    *(f32x4*)(orow + 4 * q4) = xv;
                }
            }
        }
    }
#undef IN
#undef BOTH
}

extern "C" void kernel_launch(void* const* d_in, const int* in_sizes, int n_in, void* d_out, int out_size, void* d_ws, size_t ws_size, hipStream_t stream) {
    static int grid = 0;
    if (grid == 0) {
        if (n_in != 37 || out_size != NL * D || ws_size < (size_t)1024 * MiB) { fprintf(stderr, "kernel_launch: unexpected shapes (n_in %d out %d ws %zu)\n", n_in, out_size, ws_size); grid = -1; return; }
        if (hipFuncSetAttribute((const void*)fwd_kernel, hipFuncAttributeMaxDynamicSharedMemorySize, LDS_BYTES) != hipSuccess) { fprintf(stderr, "kernel_launch: hipFuncSetAttribute failed\n"); grid = -1; return; }
        int dev = 0, cus = 0;
        if (hipGetDevice(&dev) != hipSuccess || hipDeviceGetAttribute(&cus, hipDeviceAttributeMultiprocessorCount, dev) != hipSuccess) { grid = -1; return; }
        grid = cus;
    }
    if (grid < 0) return;
    (void)hipMemsetAsync((char*)d_ws + WS_CTL, 0, CTL_BYTES, stream);
    Args a{};
    for (int i = 0; i < 37; ++i) a.in[i] = (const float*)d_in[i];
    a.out = (float*)d_out; a.ws = (unsigned char*)d_ws;
    constexpr int NPH = 16;
    const int last = (MK_LAST_PHASE < NPH - 1) ? MK_LAST_PHASE : NPH - 1;
#if MK_ONE_LAUNCH
    a.ph_lo = 0; a.ph_hi = last + 1;
    fwd_kernel<<<grid, NTHREADS, LDS_BYTES, stream>>>(a);
#else
    for (int ph = 0; ph <= last; ++ph) for (int rep = 0; rep < 1 + ((MK_REP_MASK >> ph) & 1); ++rep) { a.ph_lo = ph; a.ph_hi = ph + 1; fwd_kernel<<<grid, NTHREADS, LDS_BYTES, stream>>>(a); }
#endif
}
```
